# Optimizing an MI355X kernel written in HIP

```python
import math
import jax
import jax.numpy as jnp
from jax import lax
import numpy as np

D_MODEL = 1024
BATCH = 1
SEQ = 16384
DEPTH = 2
DEC_BATCH = 128
DEC_SEQ = 8
PAST_LEN = 16384
PAGE_SIZE = 128

N_HEADS = 16
N_KV_HEADS = 4
GROUP = N_HEADS // N_KV_HEADS
HEAD_DIM = D_MODEL // N_HEADS
WINDOW = 128
ROPE_THETA = 10000.0
ATTN_SCALE = 1.0 / math.sqrt(HEAD_DIM)
RET_HEADS = 4
RET_QK_DIM = D_MODEL // RET_HEADS
RET_V_DIM = 2 * D_MODEL // RET_HEADS
RET_CHUNK = 128
RET_THETA = 10000.0
FFN_DIM = 2816
LN_EPS = 1e-5
ALPHA = (2.0 * DEPTH) ** 0.25
BETA = (8.0 * DEPTH) ** -0.25
N_MIXERS = 2
N_ATTN_LAYERS = (DEPTH + 1) // 2
N_RET_LAYERS = DEPTH // 2

kernel_name = "hybrid_swa_sink_retention_macaron_deepnorm_step"

F32 = jnp.float32


def _layer_norm(x, g, b):
    xf = x.astype(F32)
    mu = jnp.mean(xf, axis=-1, keepdims=True)
    var = jnp.mean(jnp.square(xf - mu), axis=-1, keepdims=True)
    y = (xf - mu) * lax.rsqrt(var + LN_EPS)
    return (y * g.astype(F32) + b.astype(F32)).astype(x.dtype)


def _swiglu(x, wg, wu, wd):
    return (jax.nn.silu(x @ wg) * (x @ wu)) @ wd


def _half_ffn(x, wg, wu, wd, g, b):
    return _layer_norm(ALPHA * x + 0.5 * _swiglu(x, wg, wu, wd), g, b)


def _rope_half(x, pos):
    d = x.shape[-1]
    inv = ROPE_THETA ** (-jnp.arange(0, d, 2, dtype=F32) / d)
    ang = pos.astype(F32)[:, None] * inv[None, :]
    c = jnp.cos(ang)[:, None, :]
    s = jnp.sin(ang)[:, None, :]
    xf = x.astype(F32)
    x1, x2 = xf[..., : d // 2], xf[..., d // 2:]
    return jnp.concatenate([x1 * c - x2 * s, x2 * c + x1 * s], axis=-1).astype(x.dtype)


def _xpos_rotate(x, pos):
    d = x.shape[-1]
    inv = 1.0 / (RET_THETA ** jnp.linspace(0.0, 1.0, d // 2, dtype=F32))
    ang = pos.astype(F32)[:, None] * inv[None, :]
    c = jnp.cos(ang)[:, None, :]
    s = jnp.sin(ang)[:, None, :]
    xf = x.astype(F32).reshape(x.shape[:-1] + (d // 2, 2))
    xe, xo = xf[..., 0], xf[..., 1]
    return jnp.stack([xe * c - xo * s, xo * c + xe * s], axis=-1).reshape(x.shape)


def _sink_softmax(scores, valid, sinks):
    sink_b = sinks.astype(F32).reshape(N_KV_HEADS, GROUP)[:, :, None, None]
    s = jnp.where(valid, scores, -jnp.inf)
    m = jnp.maximum(jnp.max(s, axis=-1, keepdims=True), sink_b)
    e = jnp.exp(s - m)
    return e / (jnp.sum(e, axis=-1, keepdims=True) + jnp.exp(sink_b - m))


def _attn_proj(x, pos, w_qkv):
    B, T, _ = x.shape
    h = x @ w_qkv
    q = h[..., : N_HEADS * HEAD_DIM].reshape(B, T, N_HEADS, HEAD_DIM)
    k = h[..., N_HEADS * HEAD_DIM:(N_HEADS + N_KV_HEADS) * HEAD_DIM].reshape(B, T, N_KV_HEADS, HEAD_DIM)
    v = h[..., (N_HEADS + N_KV_HEADS) * HEAD_DIM:].reshape(B, T, N_KV_HEADS, HEAD_DIM)
    return _rope_half(q, pos), _rope_half(k, pos), v


def _swa_prompt(x, w_qkv, w_o, sinks):
    B, T, _ = x.shape
    q, k, v = _attn_proj(x, jnp.arange(T), w_qkv)
    nb = T // WINDOW
    qb = q.reshape(B, nb, WINDOW, N_KV_HEADS, GROUP, HEAD_DIM)
    kb = k.reshape(B, nb, WINDOW, N_KV_HEADS, HEAD_DIM)
    vb = v.reshape(B, nb, WINDOW, N_KV_HEADS, HEAD_DIM)

    def with_prev(a):
        prev = jnp.pad(a[:, :-1], ((0, 0), (1, 0), (0, 0), (0, 0), (0, 0)))
        return jnp.concatenate([prev, a], axis=2)

    kc, vc = with_prev(kb), with_prev(vb)
    scores = jnp.einsum('bnqkgd,bnskd->bnkgqs', qb, kc).astype(F32) * ATTN_SCALE
    blk = jnp.arange(nb)[:, None, None]
    qi = jnp.arange(WINDOW)[None, :, None]
    si = jnp.arange(2 * WINDOW)[None, None, :]
    dist = qi + WINDOW - si
    kpos = blk * WINDOW - WINDOW + si
    valid = (dist >= 0) & (dist < WINDOW) & (kpos >= 0)
    p = _sink_softmax(scores, valid[None, :, None, None], sinks)
    o = jnp.einsum('bnkgqs,bnskd->bnqkgd', p.astype(vc.dtype), vc).reshape(B, T, N_HEADS * HEAD_DIM)
    return o @ w_o, k[:, T - WINDOW:], v[:, T - WINDOW:]


def _swa_sample(x, k_buf, v_buf, w_qkv, w_o, sinks):
    B, L, _ = x.shape
    pos = PAST_LEN + jnp.arange(L)
    q, k, v = _attn_proj(x, pos, w_qkv)
    kall = jnp.concatenate([k_buf.astype(k.dtype), k], axis=1)
    vall = jnp.concatenate([v_buf.astype(v.dtype), v], axis=1)
    kpos = jnp.concatenate([PAST_LEN - WINDOW + jnp.arange(WINDOW), pos])
    dist = pos[:, None] - kpos[None, :]
    valid = (dist >= 0) & (dist < WINDOW) & (kpos >= 0)[None, :]
    qg = q.reshape(B, L, N_KV_HEADS, GROUP, HEAD_DIM)
    scores = jnp.einsum('bqkgd,bskd->bkgqs', qg, kall).astype(F32) * ATTN_SCALE
    p = _sink_softmax(scores, valid, sinks)
    o = jnp.einsum('bkgqs,bskd->bqkgd', p.astype(vall.dtype), vall).reshape(B, L, N_HEADS * HEAD_DIM)
    return o @ w_o, kall[:, -WINDOW:], vall[:, -WINDOW:]


def _ret_log_decay():
    return jnp.log(1.0 - 2.0 ** (-5.0 - jnp.arange(RET_HEADS, dtype=F32)))


def _ret_proj(x, pos, w_in):
    B, T, _ = x.shape
    h = x @ w_in
    nq = RET_HEADS * RET_QK_DIM
    nv = RET_HEADS * RET_V_DIM
    q = h[..., :nq].reshape(B, T, RET_HEADS, RET_QK_DIM)
    k = h[..., nq:2 * nq].reshape(B, T, RET_HEADS, RET_QK_DIM)
    v = h[..., 2 * nq:2 * nq + nv].reshape(B, T, RET_HEADS, RET_V_DIM).astype(F32)
    g = h[..., 2 * nq + nv:]
    q = _xpos_rotate(q, pos)
    k = _xpos_rotate(k, pos) * (RET_QK_DIM ** -0.5)
    return q, k, v, g


def _retention_chunk(S, q, k, v, lg):
    L = q.shape[1]
    idx = jnp.arange(L, dtype=F32)
    diff = idx[:, None] - idx[None, :]
    causal = diff >= 0
    dmat = jnp.where(causal[None], jnp.exp(lg[:, None, None] * jnp.where(causal, diff, 0.0)[None]), 0.0)
    att = jnp.einsum('bihd,bjhd->bhij', q, k) * dmat[None]
    o = jnp.einsum('bhij,bjhe->bihe', att, v)
    xi = jnp.exp(lg[None, :] * (idx[:, None] + 1.0))
    o = o + jnp.einsum('bihd,bhde->bihe', q, S) * xi[None, :, :, None]
    zeta = jnp.exp(lg[None, :] * (L - 1.0 - idx[:, None]))
    S_new = jnp.exp(lg * L)[None, :, None, None] * S + jnp.einsum('bjhd,bjhe->bhde', k * zeta[None, :, :, None], v)
    return S_new, o


def _retention_out(o, g, w_o, dtype):
    B, T = o.shape[:2]
    mu = jnp.mean(o, axis=-1, keepdims=True)
    var = jnp.mean(jnp.square(o - mu), axis=-1, keepdims=True)
    on = ((o - mu) * lax.rsqrt(var + LN_EPS)).reshape(B, T, RET_HEADS * RET_V_DIM)
    y = jax.nn.silu(g.astype(F32)) * on
    return y.astype(dtype) @ w_o


def _retention_prompt(x, w_in, w_o, lg):
    B, T, _ = x.shape
    q, k, v, g = _ret_proj(x, jnp.arange(T), w_in)
    nc = T // RET_CHUNK

    def to_chunks(a):
        return a.reshape((B, nc, RET_CHUNK) + a.shape[2:]).swapaxes(0, 1)

    S0 = jnp.zeros((B, RET_HEADS, RET_QK_DIM, RET_V_DIM), F32)
    S_fin, o = lax.scan(lambda S, c: _retention_chunk(S, c[0], c[1], c[2], lg), S0,
                        (to_chunks(q), to_chunks(k), to_chunks(v)))
    o = o.swapaxes(0, 1).reshape(B, T, RET_HEADS, RET_V_DIM)
    return _retention_out(o, g, w_o, x.dtype), S_fin


def _retention_sample(x, S, w_in, w_o, lg):
    B, L, _ = x.shape
    q, k, v, g = _ret_proj(x, PAST_LEN + jnp.arange(L), w_in)
    S_new, o = _retention_chunk(S.astype(F32), q, k, v, lg)
    return _retention_out(o, g, w_o, x.dtype), S_new


def setup_inputs(seed: int = 0) -> dict:
    key = jax.random.key(seed)
    ks = jax.random.split(key, 20)
    n = jax.random.normal
    D, F = D_MODEL, FFN_DIM
    qkv_w = (N_HEADS + 2 * N_KV_HEADS) * HEAD_DIM
    ret_in_w = RET_HEADS * (2 * RET_QK_DIM + 2 * RET_V_DIM)
    return {
        "x_prompt": n(ks[0], (BATCH, SEQ, D), F32),
        "x_sample": n(ks[1], (DEC_BATCH, DEC_SEQ, D), F32),
        "cache_k_win": n(ks[2], (N_ATTN_LAYERS, DEC_BATCH, WINDOW, N_KV_HEADS, HEAD_DIM), F32),
        "cache_v_win": n(ks[3], (N_ATTN_LAYERS, DEC_BATCH, WINDOW, N_KV_HEADS, HEAD_DIM), F32),
        "state_ret": 0.1 * n(ks[4], (N_RET_LAYERS, DEC_BATCH, RET_HEADS, RET_QK_DIM, RET_V_DIM), F32),
        "ffn1_w_gate": n(ks[5], (DEPTH, D, F), F32) * D ** -0.5,
        "ffn1_w_up": n(ks[6], (DEPTH, D, F), F32) * D ** -0.5,
        "ffn1_w_down": n(ks[7], (DEPTH, F, D), F32) * (F ** -0.5 * BETA),
        "ffn2_w_gate": n(ks[8], (DEPTH, D, F), F32) * D ** -0.5,
        "ffn2_w_up": n(ks[9], (DEPTH, D, F), F32) * D ** -0.5,
        "ffn2_w_down": n(ks[10], (DEPTH, F, D), F32) * (F ** -0.5 * BETA),
        "ln_g": 1.0 + 0.02 * n(ks[11], (DEPTH, 3, D), F32),
        "ln_b": 0.02 * n(ks[12], (DEPTH, 3, D), F32),
        "attn_w_qkv": n(ks[13], (N_ATTN_LAYERS, D, qkv_w), F32) * D ** -0.5,
        "attn_w_o": n(ks[14], (N_ATTN_LAYERS, N_HEADS * HEAD_DIM, D), F32) * ((N_HEADS * HEAD_DIM) ** -0.5 * BETA),
        "attn_sinks": n(ks[15], (N_ATTN_LAYERS, N_HEADS), F32),
        "ret_w_in": n(ks[16], (N_RET_LAYERS, D, ret_in_w), F32) * D ** -0.5,
        "ret_w_o": n(ks[17], (N_RET_LAYERS, RET_HEADS * RET_V_DIM, D), F32) * ((RET_HEADS * RET_V_DIM) ** -0.5 * BETA),
    }


def reference(x_prompt, x_sample, cache_k_win, cache_v_win, state_ret,
              ffn1_w_gate, ffn1_w_up, ffn1_w_down, ffn2_w_gate, ffn2_w_up, ffn2_w_down,
              ln_g, ln_b, attn_w_qkv, attn_w_o, attn_sinks, ret_w_in, ret_w_o):
    xp, xs = x_prompt, x_sample
    lg = _ret_log_decay()
    kp_l, vp_l, ks_l, vs_l, sp_l, ss_l = [], [], [], [], [], []
    for i in range(DEPTH):
        xp = _half_ffn(xp, ffn1_w_gate[i], ffn1_w_up[i], ffn1_w_down[i], ln_g[i, 0], ln_b[i, 0])
        xs = _half_ffn(xs, ffn1_w_gate[i], ffn1_w_up[i], ffn1_w_down[i], ln_g[i, 0], ln_b[i, 0])
        j = i // N_MIXERS
        if i % N_MIXERS == 0:
            mp, kp, vp = _swa_prompt(xp, attn_w_qkv[j], attn_w_o[j], attn_sinks[j])
            ms, kS, vS = _swa_sample(xs, cache_k_win[j], cache_v_win[j], attn_w_qkv[j], attn_w_o[j], attn_sinks[j])
            kp_l.append(kp.astype(x_prompt.dtype))
            vp_l.append(vp.astype(x_prompt.dtype))
            ks_l.append(kS.astype(cache_k_win.dtype))
            vs_l.append(vS.astype(cache_v_win.dtype))
        else:
            mp, sp = _retention_prompt(xp, ret_w_in[j], ret_w_o[j], lg)
            ms, sS = _retention_sample(xs, state_ret[j], ret_w_in[j], ret_w_o[j], lg)
            sp_l.append(sp.astype(x_prompt.dtype))
            ss_l.append(sS.astype(state_ret.dtype))
        xp = _layer_norm(ALPHA * xp + mp, ln_g[i, 1], ln_b[i, 1])
        xs = _layer_norm(ALPHA * xs + ms, ln_g[i, 1], ln_b[i, 1])
        xp = _half_ffn(xp, ffn2_w_gate[i], ffn2_w_up[i], ffn2_w_down[i], ln_g[i, 2], ln_b[i, 2])
        xs = _half_ffn(xs, ffn2_w_gate[i], ffn2_w_up[i], ffn2_w_down[i], ln_g[i, 2], ln_b[i, 2])
    return (xp, xs, jnp.stack(kp_l), jnp.stack(vp_l), jnp.stack(ks_l), jnp.stack(vs_l), jnp.stack(sp_l), jnp.stack(ss_l))
```

```cpp
#include <hip/hip_runtime.h>
#include <hip/hip_cooperative_groups.h>
#include <cstdio>
namespace cg = cooperative_groups;
#ifndef ONE_LAUNCH
#define ONE_LAUNCH 1
#endif
__device__ __forceinline__ int otid() { int t = threadIdx.x; asm volatile("" : "+v"(t)); return t; }
__device__ __forceinline__ int obid() { int t = blockIdx.x; asm volatile("" : "+s"(t)); return t; }
namespace pg8 {
#define PG8_LAS __attribute__((address_space(3)))
typedef unsigned short bf16_t;
typedef short bf16x8 __attribute__((ext_vector_type(8)));
typedef float f32x4 __attribute__((ext_vector_type(4)));
typedef unsigned u32x4 __attribute__((ext_vector_type(4)));
constexpr int BM = 256, BK = 64, HALF = 128, HTB = HALF * BK * 2  , STAGE_BYTES = 8 * HTB, NXCD = 8, WGM = 8;

__host__ __device__ __forceinline__ int lds_byte(int r, int c) { const int st = (r >> 4) * 2 + (c >> 5), rr = r & 15, cc = c & 31, ob = rr * 64 + cc * 2; return st * 1024 + (ob ^ (((ob >> 9) & 1) << 5)); }
__host__ __device__ __forceinline__ void stage_rc(int b, int& R, int& C) { const int st = b / 1024, sb = b % 1024, swz = sb ^ (((sb >> 9) & 1) << 5); R = (st >> 1) * 16 + swz / 64; C = (st & 1) * 32 + (swz % 64) / 2; }
__host__ __device__ __forceinline__ int perm32(int rho) { const int n = rho >> 4, i = rho & 15; return 8 * (i >> 2) + 4 * n + (i & 3); }

struct Unit { int pm, pn; };
struct Gemm { const bf16_t* A; const bf16_t* Bt; int M, N, K; };

struct StaticOrder {
    int nM, nN, nwg, G, c;
    __host__ __device__ void init(int M, int N, int G_, int c_) { nM = M / BM; nN = N / BM; nwg = nM * nN; G = G_; c = c_; }
    __host__ __device__ bool next(int i, Unit& u) const {
        const long L = (long)i * G + c; if (L >= nwg) return false;
        int wgid = (int)L; { const int q = nwg / NXCD, r = nwg % NXCD, xcd = wgid % NXCD, off = wgid / NXCD; wgid = (xcd < r ? xcd * (q + 1) : r * (q + 1) + (xcd - r) * q) + off; }
        const int nig = WGM * nN, gid = wgid / nig, fm = gid * WGM, gsz = (nM - fm) < WGM ? (nM - fm) : WGM;
        u.pm = fm + ((wgid % nig) % gsz); u.pn = (wgid % nig) / gsz; return true;
    }
    __device__ __forceinline__ void a_ready(const Unit&) const {}
    __device__ __forceinline__ void done(const Unit&) const {}
};
struct CountedOrder : StaticOrder {
    const unsigned* ready; unsigned need; unsigned* tmo;
    __device__ __forceinline__ void a_ready(const Unit& u) const {
        if (threadIdx.x < 64) {
            const unsigned long long t0 = __builtin_amdgcn_s_memrealtime(); unsigned polls = 0;
            while ((unsigned)__builtin_amdgcn_readfirstlane(__hip_atomic_load(ready + 64 * u.pm, __ATOMIC_RELAXED, __HIP_MEMORY_SCOPE_AGENT)) < need) {
                if ((++polls & 255u) == 0u && __builtin_amdgcn_readfirstlane(__hip_atomic_load(tmo, __ATOMIC_RELAXED, __HIP_MEMORY_SCOPE_AGENT)) != 0u) break;
                if (__builtin_amdgcn_s_memrealtime() - t0 > 2000000ull) {
                    if (threadIdx.x == 0) { unsigned expect = 0u; __hip_atomic_compare_exchange_strong(tmo + 1, &expect, 0x600u | (unsigned)(u.pm & 0xff), __ATOMIC_RELAXED, __ATOMIC_RELAXED, __HIP_MEMORY_SCOPE_AGENT); __hip_atomic_store(tmo, 1u, __ATOMIC_RELAXED, __HIP_MEMORY_SCOPE_AGENT); }
                    break; }
                __builtin_amdgcn_s_sleep(2); }
            __builtin_amdgcn_fence(__ATOMIC_ACQUIRE, "agent");
            asm volatile("s_waitcnt vmcnt(0)" ::: "memory");
        }
#if !defined(BROKEN_HOOK_NO_BARRIER)
        asm volatile("" ::: "memory"); __builtin_amdgcn_s_barrier(); asm volatile("" ::: "memory");
#endif
    }
};

__device__ __forceinline__ unsigned cvt_pk_bf16(float lo, float hi) { unsigned r; asm volatile("v_cvt_pk_bf16_f32 %0, %1, %2" : "=v"(r) : "v"(lo), "v"(hi)); return r; }
typedef float f32x2 __attribute__((ext_vector_type(2)));
__device__ __forceinline__ f32x2 gelu_pk(f32x2 v) {
    const f32x2 av = __builtin_elementwise_abs(v), d = av * 0.2316418882f + 1.0f;
    f32x2 t; t.x = __builtin_amdgcn_rcpf(d.x); t.y = __builtin_amdgcn_rcpf(d.y);
    f32x2 q = t * 0.5307027145f + (-0.7265760135f); q = q * t + 0.7107068705f; q = q * t + (-0.142248368f); q = q * t + 0.127414796f; q = q * t;
    const f32x2 s = (v * v) * (-0.72134752044f);
    f32x2 e; e.x = __builtin_amdgcn_exp2f(s.x); e.y = __builtin_amdgcn_exp2f(s.y);
    const f32x2 m = v * (q * e), r = v - m;
    f32x2 o; o.x = v.x < 0.f ? m.x : r.x; o.y = v.y < 0.f ? m.y : r.y; return o;
}

template <class Epi, class Sched, bool STAMP = false>
__device__ __forceinline__ void gemm_phase(PG8_LAS unsigned char* lds, const Gemm g, const Sched& S, const Epi& E, unsigned long long* stamps) {
    const int tid = otid(), wid = __builtin_amdgcn_readfirstlane(tid >> 6), lane = tid & 63, wr = wid >> 2, wc = wid & 3, fr = lane & 15, fq = lane >> 4;
    const int K = g.K, nt = K / BK;
    int ts_lo = 0, ts_hi = 0, nts = 0; const unsigned long long rt_entry = STAMP ? (unsigned long long)wall_clock64() : 0ull;
#define PG8_STAMP() do { if (STAMP && wid == 0 && nts < 64) { const unsigned long long _c = (unsigned long long)clock64(); \
        ts_lo = (lane == nts) ? (int)(unsigned)_c : ts_lo; ts_hi = (lane == nts) ? (int)(unsigned)(_c >> 32) : ts_hi; ++nts; } } while (0)
    PG8_STAMP();
    unsigned voffA[2], voffB[2];
#pragma unroll
    for (int i = 0; i < 2; ++i) { int R, C; stage_rc(tid * 16 + i * 8192, R, C); const int Rb = Epi::PERM ? ((R & ~31) + perm32(R & 31)) : R;
        voffA[i] = (unsigned)(R * K + C) * 2u; voffB[i] = (unsigned)(Rb * K + C) * 2u; }
    const size_t kstep = (size_t)(BK * 2);
    const size_t hstep = (size_t)HALF * K * 2;
    const size_t tstep = 2 * hstep;
    const unsigned ldsw = (unsigned)wid * 1024u;
    const int aoff = lds_byte(wr * 64 + fr, fq * 8), boff = lds_byte(wc * 32 + fr, fq * 8);
#define PG8_SA(b, h) (((b) * 2 + (h)) * HTB)
#define PG8_SB(b, h) ((4 + (b) * 2 + (h)) * HTB)
#define PG8_STAGE(bufoff, gbase, voff) do { _Pragma("unroll") for (int _i = 0; _i < 2; ++_i) \
        __builtin_amdgcn_global_load_lds((const unsigned*)((const char*)(gbase) + (voff)[_i]), (PG8_LAS unsigned*)(lds + (bufoff) + ldsw + _i * 8192), 16, 0, 0); } while (0)
#define PG8_LDA(dst, b, h) do { _Pragma("unroll") for (int m = 0; m < 4; ++m) _Pragma("unroll") for (int k = 0; k < 2; ++k) dst[m][k] = *(const PG8_LAS bf16x8*)(lds + PG8_SA(b, h) + aoff + m * 2048 + k * 1024); } while (0)
#define PG8_LDB(dst, b, h) do { _Pragma("unroll") for (int n = 0; n < 2; ++n) _Pragma("unroll") for (int k = 0; k < 2; ++k) dst[n][k] = *(const PG8_LAS bf16x8*)(lds + PG8_SB(b, h) + boff + n * 2048 + k * 1024); } while (0)
#define PG8_MMA(ai, bj, At, Bt) do { __builtin_amdgcn_s_setprio(1); _Pragma("unroll") for (int m = 0; m < 4; ++m) _Pragma("unroll") for (int n = 0; n < 2; ++n) _Pragma("unroll") for (int k = 0; k < 2; ++k) \
        acc[ai][bj][m][n] = __builtin_amdgcn_mfma_f32_16x16x32_bf16(Bt[n][k], At[m][k], acc[ai][bj][m][n], 0, 0, 0); __builtin_amdgcn_s_setprio(0); } while (0)
#define PG8_WAIT_V(n) asm volatile("s_waitcnt vmcnt(" #n ")" ::: "memory")
#define PG8_WAIT_L(n) asm volatile("s_waitcnt lgkmcnt(" #n ")" ::: "memory")
#define PG8_BAR __builtin_amdgcn_s_barrier()
#define PG8_SCHED __builtin_amdgcn_sched_barrier(0)
    Unit cur, nxt; int ui = 0;
    if (!S.next(0, cur)) return;
    f32x4 acc[2][2][4][2];
#pragma unroll
    for (int a = 0; a < 2; ++a)
#pragma unroll
        for (int b = 0; b < 2; ++b)
#pragma unroll
            for (int m = 0; m < 4; ++m)
#pragma unroll
                for (int n = 0; n < 2; ++n) acc[a][b][m][n] = (f32x4){0.f, 0.f, 0.f, 0.f};
    bf16x8 At[4][2], B0[2][2], B1[2][2];
    const char* cA = (const char*)g.A + (size_t)cur.pm * tstep; const char* cB = (const char*)g.Bt + (size_t)cur.pn * tstep;
    S.a_ready(cur);
    PG8_STAGE(PG8_SB(0, 0), cB, voffB); PG8_STAGE(PG8_SA(0, 0), cA, voffA); PG8_STAGE(PG8_SB(0, 1), cB + hstep, voffB); PG8_STAGE(PG8_SA(0, 1), cA + hstep, voffA);
    if (wr == 1) PG8_BAR;
    PG8_WAIT_V(4); PG8_BAR;
    PG8_STAGE(PG8_SB(1, 0), cB + kstep, voffB); PG8_STAGE(PG8_SA(1, 0), cA + kstep, voffA); PG8_STAGE(PG8_SB(1, 1), cB + hstep + kstep, voffB);
    PG8_WAIT_V(6); PG8_BAR;
    PG8_STAMP();
    for (;;) {
        const bool has_next = S.next(ui + 1, nxt);
        const char* nA = has_next ? (const char*)g.A + (size_t)nxt.pm * tstep : cA; const char* nB = has_next ? (const char*)g.Bt + (size_t)nxt.pn * tstep : cB;
        for (int t = 0; t < nt; t += 2) {
            const bool last = (t == nt - 2);
            const char* a1 = cA + (size_t)(t + 1) * kstep;
            const char* a2 = last ? nA : cA + (size_t)(t + 2) * kstep; const char* b2 = last ? nB : cB + (size_t)(t + 2) * kstep;
            const char* a3 = a2 + kstep; const char* b3 = b2 + kstep;
            if (last && has_next) S.a_ready(nxt);
            PG8_LDB(B0, 0, 0); PG8_SCHED; PG8_LDA(At, 0, 0); PG8_STAGE(PG8_SA(1, 1), a1 + hstep, voffA);
            PG8_WAIT_L(8); PG8_BAR; PG8_WAIT_L(0); PG8_MMA(0, 0, At, B0); PG8_BAR; PG8_SCHED;
            PG8_LDB(B1, 0, 1); PG8_STAGE(PG8_SB(0, 0), b2, voffB);
            PG8_BAR; PG8_WAIT_L(0); PG8_MMA(0, 1, At, B1); PG8_BAR;
            PG8_LDA(At, 0, 1); PG8_STAGE(PG8_SA(0, 0), a2, voffA);
            PG8_BAR; PG8_WAIT_L(0); PG8_MMA(1, 0, At, B0); PG8_BAR; PG8_SCHED;
            PG8_STAGE(PG8_SB(0, 1), b2 + hstep, voffB);
            PG8_WAIT_V(6); PG8_BAR; PG8_MMA(1, 1, At, B1); PG8_BAR;
            PG8_LDB(B0, 1, 0); PG8_SCHED; PG8_LDA(At, 1, 0); PG8_STAGE(PG8_SA(0, 1), a2 + hstep, voffA);
            PG8_WAIT_L(8); PG8_BAR; PG8_WAIT_L(0); PG8_MMA(0, 0, At, B0); PG8_BAR; PG8_SCHED;
            PG8_LDB(B1, 1, 1); PG8_STAGE(PG8_SB(1, 0), b3, voffB);
            PG8_BAR; PG8_WAIT_L(0); PG8_MMA(0, 1, At, B1); PG8_BAR;
            PG8_LDA(At, 1, 1); PG8_STAGE(PG8_SA(1, 0), a3, voffA);
            PG8_BAR; PG8_WAIT_L(0); PG8_MMA(1, 0, At, B0); PG8_BAR; PG8_SCHED;
            PG8_STAGE(PG8_SB(1, 1), b3 + hstep, voffB);
            PG8_WAIT_V(6); PG8_BAR; PG8_MMA(1, 1, At, B1); PG8_BAR;
        }
        PG8_STAMP();
        if constexpr (!Epi::AFTER_DRAIN) { E(acc, cur, wr, wc, fr, fq); S.done(cur); }
        PG8_STAMP();
        if (!has_next) break;
#pragma unroll
        for (int a = 0; a < 2; ++a)
#pragma unroll
            for (int b = 0; b < 2; ++b)
#pragma unroll
                for (int m = 0; m < 4; ++m)
#pragma unroll
                    for (int n = 0; n < 2; ++n) acc[a][b][m][n] = (f32x4){0.f, 0.f, 0.f, 0.f};
        cur = nxt; cA = nA; cB = nB; ++ui;
    }
    PG8_WAIT_V(0);
    if (wr == 0) PG8_BAR;
    PG8_BAR;
    if constexpr (Epi::AFTER_DRAIN) { E.fused(acc, cur, wr, wc, fr, fq, lds, wid, lane); S.done(cur); }
    PG8_STAMP();
    if (STAMP && wid == 0) { stamps[lane] = lane < nts ? (((unsigned long long)(unsigned)ts_hi << 32) | (unsigned)ts_lo) : 0ull;
        if (lane == 62) stamps[62] = rt_entry; if (lane == 63) stamps[63] = (unsigned long long)wall_clock64(); }
#undef PG8_STAMP
#undef PG8_SA
#undef PG8_SB
#undef PG8_STAGE
#undef PG8_LDA
#undef PG8_LDB
#undef PG8_MMA
#undef PG8_WAIT_V
#undef PG8_WAIT_L
#undef PG8_BAR
#undef PG8_SCHED
}
}

using pg8::bf16_t; using pg8::bf16x8; using pg8::f32x4; using pg8::u32x4; using pg8::cvt_pk_bf16;
typedef unsigned u32x2 __attribute__((ext_vector_type(2)));
typedef float f32x2 __attribute__((ext_vector_type(2)));

constexpr int DM = 1024, FF = 2816, TP = 16384, MS = 1024, MT = 17408;
constexpr int NQKV = 1536, NRIN = 6144, NPOS = 16392;
constexpr float LN_EPS = 1e-5f;
constexpr float ALPHA = 1.4142135623730951f;
constexpr int LDS_BYTES = 131072;
constexpr int NPH = 24;

constexpr size_t OUT_Y = 0;
constexpr size_t OUT_KP = (size_t)MT * DM;
constexpr size_t OUT_VP = OUT_KP + 32768;
constexpr size_t OUT_KS = OUT_VP + 32768;
constexpr size_t OUT_VS = OUT_KS + 4194304;
constexpr size_t OUT_SP = OUT_VS + 4194304;
constexpr size_t OUT_SS = OUT_SP + 524288;
constexpr size_t OUT_END = OUT_SS + 67108864;

constexpr size_t al256(size_t x) { return (x + 255) & ~(size_t)255; }
constexpr size_t SZ_WGU = (size_t)2 * FF * DM * 2, SZ_WD = (size_t)DM * FF * 2;
constexpr size_t WS_WGU = 0;
constexpr size_t WS_WD = WS_WGU + 4 * SZ_WGU;
constexpr size_t WS_WQKV = WS_WD + 4 * SZ_WD;
constexpr size_t WS_WO = WS_WQKV + (size_t)NQKV * DM * 2;
constexpr size_t WS_WRIN = WS_WO + (size_t)DM * DM * 2;
constexpr size_t WS_WRO = WS_WRIN + (size_t)NRIN * DM * 2;
constexpr size_t WS_ROPEA = WS_WRO + (size_t)DM * 2048 * 2;
constexpr size_t WS_ROPER = WS_ROPEA + (size_t)NPOS * 32 * 8;
constexpr size_t WS_XF = al256(WS_ROPER + (size_t)NPOS * 128 * 8);
constexpr size_t WS_XB = WS_XF + (size_t)MT * DM * 4;
constexpr size_t WS_Z = WS_XB + (size_t)MT * DM * 2;
constexpr size_t WS_H = WS_Z + (size_t)MT * DM * 4;
constexpr size_t WS_MIX = WS_H + (size_t)MT * FF * 2;
constexpr size_t WS_QR = WS_MIX;
constexpr size_t WS_KR = WS_QR + (size_t)MT * 1024 * 2;
constexpr size_t WS_VB = WS_KR + (size_t)MT * 256 * 2;
constexpr size_t WS_OB = WS_VB + (size_t)MT * 256 * 2;
constexpr size_t WS_RQ = WS_MIX;
constexpr size_t WS_RKZ = WS_RQ + (size_t)MT * 1024 * 2;
constexpr size_t WS_RV = WS_RKZ + (size_t)MT * 1024 * 2;
constexpr size_t WS_RG = WS_RV + (size_t)MT * 2048 * 2;
constexpr size_t WS_U = WS_RG + (size_t)MT * 2048 * 2;
constexpr size_t WS_SB = WS_U + (size_t)128 * 4 * 512 * 256 * 4;
constexpr size_t WS_END = WS_SB + (size_t)128 * 4 * 512 * 256 * 2;
constexpr size_t WS_ATT = WS_XB;
constexpr size_t WS_ORET = WS_Z;
constexpr size_t WS_YB = WS_RQ;

struct Params { const float* in[18]; float* out; unsigned char* ws; int lo, hi; };

__device__ __forceinline__ float bf2f(unsigned short b) { return __uint_as_float(((unsigned)b) << 16); }
__device__ __forceinline__ float bflo(unsigned w) { return __uint_as_float(w << 16); }
__device__ __forceinline__ float bfhi(unsigned w) { return __uint_as_float(w & 0xffff0000u); }
__device__ __forceinline__ float lg2gamma(int h) { return log2f(1.0f - exp2f(-5.0f - (float)h)); }
__device__ __forceinline__ float silu_f(float x) { return x / (1.0f + __expf(-x)); }
__device__ __forceinline__ float wave_sum(float v) {
    v += __shfl_xor(v, 32); v += __shfl_xor(v, 16); v += __shfl_xor(v, 8); v += __shfl_xor(v, 4); v += __shfl_xor(v, 2); v += __shfl_xor(v, 1); return v; }

struct EpiSwiGLU {
    static constexpr bool PERM = false, AFTER_DRAIN = false;
    bf16_t* H;
    __device__ __forceinline__ void operator()(const f32x4 (&acc)[2][2][4][2], const pg8::Unit& u, int wr, int wc, int fr, int fq) const {
        const int row0 = u.pm * 256 + wr * 64 + fr, col0 = u.pn * 128 + wc * 32 + 4 * fq;
#pragma unroll
        for (int ai = 0; ai < 2; ++ai)
#pragma unroll
            for (int m = 0; m < 4; ++m) {
                bf16_t* rowp = H + (size_t)(row0 + ai * 128 + m * 16) * FF + col0;
#pragma unroll
                for (int n = 0; n < 2; ++n) {
                    const f32x4 g = acc[ai][0][m][n], up = acc[ai][1][m][n];
                    u32x2 w; w.x = cvt_pk_bf16(silu_f(g[0]) * up[0], silu_f(g[1]) * up[1]); w.y = cvt_pk_bf16(silu_f(g[2]) * up[2], silu_f(g[3]) * up[3]);
                    *(u32x2*)(rowp + n * 16) = w;
                }
            }
    }
};
struct EpiResid {
    static constexpr bool PERM = false, AFTER_DRAIN = false;
    const float* X; float* Z; float scale;
    __device__ __forceinline__ void operator()(const f32x4 (&acc)[2][2][4][2], const pg8::Unit& u, int wr, int wc, int fr, int fq) const {
        const int row0 = u.pm * 256 + wr * 64 + fr, col0 = u.pn * 256 + wc * 32 + 4 * fq;
#pragma unroll
        for (int ai = 0; ai < 2; ++ai)
#pragma unroll
            for (int m = 0; m < 4; ++m) {
                const size_t off = (size_t)(row0 + ai * 128 + m * 16) * DM + col0;
#pragma unroll
                for (int bj = 0; bj < 2; ++bj)
#pragma unroll
                    for (int n = 0; n < 2; ++n) {
                        const f32x4 x = *(const f32x4*)(X + off + bj * 128 + n * 16);
                        *(f32x4*)(Z + off + bj * 128 + n * 16) = x * ALPHA + acc[ai][bj][m][n] * scale;
                    }
            }
    }
};
struct EpiQKV {
    static constexpr bool PERM = false, AFTER_DRAIN = false;
    bf16_t* Qr; bf16_t* Kr; bf16_t* Vb; const float* ropeA; float* out;
    __device__ __forceinline__ void operator()(const f32x4 (&acc)[2][2][4][2], const pg8::Unit& u, int wr, int wc, int fr, int fq) const {
        const int pn = u.pn;
#pragma unroll
        for (int ai = 0; ai < 2; ++ai)
#pragma unroll
            for (int m = 0; m < 4; ++m) {
                const int row = u.pm * 256 + ai * 128 + wr * 64 + m * 16 + fr;
                const int pos = row < TP ? row : TP + (row & 7);
                long wk = -1;
                bool wsamp = false;
                if (row >= TP) { const int b = (row - TP) >> 3, t = row & 7; wk = ((long)(b * 128 + 120 + t) * 4) * 64; wsamp = true; }
                else if (row >= TP - 128) { wk = ((long)(row - (TP - 128)) * 4) * 64; }
                if (pn < 5) {
#pragma unroll
                    for (int bj = 0; bj < 2; ++bj)
#pragma unroll
                        for (int n = 0; n < 2; ++n) {
                            const int hl = 2 * bj + (wc >> 1);
                            const int i = 2 * (8 * (wc & 1) + 4 * n + fq);
                            const f32x4 cs = *(const f32x4*)(ropeA + ((size_t)pos * 32 + i) * 2);
                            const f32x4 v = acc[ai][bj][m][n];
                            float lo0 = v[0] * cs[0] - v[1] * cs[1], hi0 = v[1] * cs[0] + v[0] * cs[1];
                            float lo1 = v[2] * cs[2] - v[3] * cs[3], hi1 = v[3] * cs[2] + v[2] * cs[3];
                            if (pn < 4) {
                                bf16_t* p = Qr + (size_t)row * 1024 + (pn * 4 + hl) * 64 + i;
                                *(unsigned*)p = cvt_pk_bf16(lo0 * 0.125f, lo1 * 0.125f);
                                *(unsigned*)(p + 32) = cvt_pk_bf16(hi0 * 0.125f, hi1 * 0.125f);
                            } else {
                                bf16_t* p = Kr + (size_t)row * 256 + hl * 64 + i;
                                *(unsigned*)p = cvt_pk_bf16(lo0, lo1);
                                *(unsigned*)(p + 32) = cvt_pk_bf16(hi0, hi1);
                                if (wk >= 0) {
                                    float* o = out + (wsamp ? OUT_KS : OUT_KP) + wk + hl * 64 + i;
                                    *(f32x2*)o = (f32x2){lo0, lo1}; *(f32x2*)(o + 32) = (f32x2){hi0, hi1};
                                }
                            }
                        }
                } else {
#pragma unroll
                    for (int bj = 0; bj < 2; ++bj)
#pragma unroll
                        for (int n = 0; n < 2; ++n) {
                            const int cc = bj * 128 + wc * 32 + n * 16 + 4 * fq;
                            const f32x4 v = acc[ai][bj][m][n];
                            u32x2 w; w.x = cvt_pk_bf16(v[0], v[1]); w.y = cvt_pk_bf16(v[2], v[3]);
                            *(u32x2*)(Vb + (size_t)row * 256 + cc) = w;
                            if (wk >= 0) *(f32x4*)(out + (wsamp ? OUT_VS : OUT_VP) + wk + cc) = v;
                        }
                }
            }
    }
};
struct EpiRet {
    static constexpr bool PERM = false, AFTER_DRAIN = false;
    bf16_t* RQ; bf16_t* RKZ; bf16_t* RV; bf16_t* RG; const float* ropeR;
    __device__ __forceinline__ void operator()(const f32x4 (&acc)[2][2][4][2], const pg8::Unit& u, int wr, int wc, int fr, int fq) const {
        const int pn = u.pn;
        const float lg = lg2gamma(pn & 3);
#pragma unroll
        for (int ai = 0; ai < 2; ++ai)
#pragma unroll
            for (int m = 0; m < 4; ++m) {
                const int row = u.pm * 256 + ai * 128 + wr * 64 + m * 16 + fr;
                const int pos = row < TP ? row : TP + (row & 7);
                if (pn < 8) {
                    float sc = 1.0f;
                    if (pn >= 4) { const int jj = row < TP ? 127 - (row & 127) : 7 - (row & 7); sc = 0.0625f * exp2f((float)jj * lg); }
                    bf16_t* dst = (pn < 4 ? RQ : RKZ) + (size_t)row * 1024 + (pn & 3) * 256;
#pragma unroll
                    for (int bj = 0; bj < 2; ++bj)
#pragma unroll
                        for (int n = 0; n < 2; ++n) {
                            const int dk = bj * 128 + wc * 32 + n * 16 + 4 * fq;
                            const f32x4 cs = *(const f32x4*)(ropeR + ((size_t)pos * 128 + (dk >> 1)) * 2);
                            const f32x4 v = acc[ai][bj][m][n];
                            const float o0 = (v[0] * cs[0] - v[1] * cs[1]) * sc, o1 = (v[1] * cs[0] + v[0] * cs[1]) * sc;
                            const float o2 = (v[2] * cs[2] - v[3] * cs[3]) * sc, o3 = (v[3] * cs[2] + v[2] * cs[3]) * sc;
                            u32x2 w; w.x = cvt_pk_bf16(o0, o1); w.y = cvt_pk_bf16(o2, o3);
                            *(u32x2*)(dst + dk) = w;
                        }
                } else {
                    const bool isg = pn >= 16;
                    bf16_t* dst = (isg ? RG : RV) + (size_t)row * 2048 + ((pn - 8) & 7) * 256;
#pragma unroll
                    for (int bj = 0; bj < 2; ++bj)
#pragma unroll
                        for (int n = 0; n < 2; ++n) {
                            const int cc = bj * 128 + wc * 32 + n * 16 + 4 * fq;
                            f32x4 v = acc[ai][bj][m][n];
                            if (isg) { v[0] = silu_f(v[0]); v[1] = silu_f(v[1]); v[2] = silu_f(v[2]); v[3] = silu_f(v[3]); }
                            u32x2 w; w.x = cvt_pk_bf16(v[0], v[1]); w.y = cvt_pk_bf16(v[2], v[3]);
                            *(u32x2*)(dst + cc) = w;
                        }
                }
            }
    }
};

__device__ void conv_job(const float* src0, const float* src1, bf16_t* dst, int K, int Nsrc, int Ndst, int mode, float* tile) {
    const int ntn = Ndst / 64, ntk = K / 64, tid = otid();
    for (int t = obid(); t < ntn * ntk; t += gridDim.x) {
        const int tn = t % ntn, tk = t / ntn, n0 = tn * 64, k0 = tk * 64;
        const int tx = tid & 63, ty = tid >> 6;
        const int v = n0 + tx; const float* s = src0; int col = v;
        if (mode == 1) { const int pn = v >> 8, bj = (v >> 7) & 1, rest = v & 127; col = pn * 128 + rest; s = bj ? src1 : src0; }
        else if (mode == 2) { if (v < 1280) { const int head = v >> 6, p = v & 63, a = p >> 2, b = p & 3; col = head * 64 + 2 * a + (b >> 1) + 32 * (b & 1); } }
        __syncthreads();
#pragma unroll
        for (int i = 0; i < 8; ++i) { const int kk = ty * 8 + i; tile[kk * 65 + tx] = s[(size_t)(k0 + kk) * Nsrc + col]; }
        __syncthreads();
        const int ny = tid >> 3, kc = (tid & 7) * 8;
        u32x4 w;
        w.x = cvt_pk_bf16(tile[(kc + 0) * 65 + ny], tile[(kc + 1) * 65 + ny]); w.y = cvt_pk_bf16(tile[(kc + 2) * 65 + ny], tile[(kc + 3) * 65 + ny]);
        w.z = cvt_pk_bf16(tile[(kc + 4) * 65 + ny], tile[(kc + 5) * 65 + ny]); w.w = cvt_pk_bf16(tile[(kc + 6) * 65 + ny], tile[(kc + 7) * 65 + ny]);
        *(u32x4*)(dst + (size_t)(n0 + ny) * K + k0 + kc) = w;
    }
}
__device__ void phase0(const Params& P, unsigned char* lds) {
    float* tile = (float*)lds; unsigned char* ws = P.ws;
    for (int l = 0; l < 2; ++l)
        for (int f = 0; f < 2; ++f) {
            const float* wg = P.in[f ? 8 : 5] + (size_t)l * DM * FF; const float* wu = P.in[f ? 9 : 6] + (size_t)l * DM * FF; const float* wd = P.in[f ? 10 : 7] + (size_t)l * FF * DM;
            conv_job(wg, wu, (bf16_t*)(ws + WS_WGU + (size_t)(l * 2 + f) * SZ_WGU), DM, FF, 2 * FF, 1, tile);
            conv_job(wd, wd, (bf16_t*)(ws + WS_WD + (size_t)(l * 2 + f) * SZ_WD), FF, DM, DM, 0, tile);
        }
    conv_job(P.in[13], P.in[13], (bf16_t*)(ws + WS_WQKV), DM, NQKV, NQKV, 2, tile);
    conv_job(P.in[14], P.in[14], (bf16_t*)(ws + WS_WO), DM, DM, DM, 0, tile);
    conv_job(P.in[16], P.in[16], (bf16_t*)(ws + WS_WRIN), DM, NRIN, NRIN, 0, tile);
    conv_job(P.in[17], P.in[17], (bf16_t*)(ws + WS_WRO), 2048, DM, DM, 0, tile);
    const size_t gt = (size_t)obid() * blockDim.x + otid(), gs = (size_t)gridDim.x * blockDim.x;
    float* ra = (float*)(ws + WS_ROPEA); float* rr = (float*)(ws + WS_ROPER);
    for (size_t i = gt; i < (size_t)NPOS * 32; i += gs) { const int pos = (int)(i >> 5), k = (int)(i & 31);
        const float inv = powf(10000.0f, -(float)(2 * k) / 64.0f); const float ang = (float)pos * inv; float s, c; sincosf(ang, &s, &c); *(f32x2*)(ra + i * 2) = (f32x2){c, s}; }
    for (size_t i = gt; i < (size_t)NPOS * 128; i += gs) { const int pos = (int)(i >> 7), k = (int)(i & 127);
        const float inv = 1.0f / powf(10000.0f, (float)k / 127.0f); const float ang = (float)pos * inv; float s, c; sincosf(ang, &s, &c); *(f32x2*)(rr + i * 2) = (f32x2){c, s}; }
    float* XF = (float*)(ws + WS_XF); bf16_t* XB = (bf16_t*)(ws + WS_XB);
    for (size_t i = gt; i < (size_t)MT * DM / 4; i += gs) {
        const size_t e = i * 4; const f32x4 v = e < (size_t)TP * DM ? *(const f32x4*)(P.in[0] + e) : *(const f32x4*)(P.in[1] + (e - (size_t)TP * DM));
        *(f32x4*)(XF + e) = v; u32x2 w; w.x = cvt_pk_bf16(v[0], v[1]); w.y = cvt_pk_bf16(v[2], v[3]); *(u32x2*)(XB + e) = w; }
}

__device__ void ln_phase(const float* Z, const float* g, const float* b, float* Xf, bf16_t* Xb) {
    const int wave = otid() >> 6, lane = otid() & 63;
    f32x4 gv[4], bv[4];
#pragma unroll
    for (int i = 0; i < 4; ++i) { gv[i] = *(const f32x4*)(g + 256 * i + 4 * lane); bv[i] = *(const f32x4*)(b + 256 * i + 4 * lane); }
    for (int r = obid() * 8 + wave; r < MT; r += gridDim.x * 8) {
        f32x4 v[4]; float s = 0.f;
#pragma unroll
        for (int i = 0; i < 4; ++i) { v[i] = *(const f32x4*)(Z + (size_t)r * DM + 256 * i + 4 * lane); s += (v[i][0] + v[i][1]) + (v[i][2] + v[i][3]); }
        const float mu = wave_sum(s) * (1.0f / 1024.0f); float q = 0.f;
#pragma unroll
        for (int i = 0; i < 4; ++i) { v[i] -= mu; q += (v[i][0] * v[i][0] + v[i][1] * v[i][1]) + (v[i][2] * v[i][2] + v[i][3] * v[i][3]); }
        const float rstd = rsqrtf(wave_sum(q) * (1.0f / 1024.0f) + LN_EPS);
#pragma unroll
        for (int i = 0; i < 4; ++i) { const f32x4 y = v[i] * rstd * gv[i] + bv[i];
            *(f32x4*)(Xf + (size_t)r * DM + 256 * i + 4 * lane) = y;
            u32x2 w; w.x = cvt_pk_bf16(y[0], y[1]); w.y = cvt_pk_bf16(y[2], y[3]); *(u32x2*)(Xb + (size_t)r * DM + 256 * i + 4 * lane) = w; }
    }
}

__device__ __forceinline__ u32x4 ld8_f32_as_bf16(const float* p) { const f32x4 a = *(const f32x4*)p, b = *(const f32x4*)(p + 4);
    u32x4 w; w.x = cvt_pk_bf16(a[0], a[1]); w.y = cvt_pk_bf16(a[2], a[3]); w.z = cvt_pk_bf16(b[0], b[1]); w.w = cvt_pk_bf16(b[2], b[3]); return w; }
__device__ void attn_phase(const Params& P, unsigned char* lds) {
    unsigned char* ws = P.ws;
    const bf16_t* Qr = (const bf16_t*)(ws + WS_QR); const bf16_t* Kr = (const bf16_t*)(ws + WS_KR); const bf16_t* Vb = (const bf16_t*)(ws + WS_VB); bf16_t* Ob = (bf16_t*)(ws + WS_OB);
    const float* cache_k = P.in[2]; const float* cache_v = P.in[3]; const float* sinks = P.in[15];
    bf16_t* Ks = (bf16_t*)lds;
    bf16_t* Vt = (bf16_t*)(lds + 23040);
    const int tid = otid(), wave = tid >> 6, lane = tid & 63, fr = lane & 15, fq = lane >> 4;
    for (int it = obid(); it < 2048 + 512; it += gridDim.x) {
        const bool samp = it >= 2048;
        int kh, q0 = 0, b = 0;
        if (!samp) { kh = it & 3; q0 = (it >> 2) * 32; } else { const int s = it - 2048; kh = s & 3; b = s >> 2; }
        __syncthreads();
        for (int c = tid; c < 1280; c += 512) {
            const int row = c >> 3, ch = c & 7; u32x4 w = (u32x4){0u, 0u, 0u, 0u};
            if (!samp) { const int kp = q0 - 128 + row; if (kp >= 0) w = *(const u32x4*)(Kr + (size_t)kp * 256 + kh * 64 + ch * 8); }
            else { if (row < 128) w = ld8_f32_as_bf16(cache_k + ((size_t)(b * 128 + row) * 4 + kh) * 64 + ch * 8);
                   else if (row < 136) w = *(const u32x4*)(Kr + (size_t)(TP + b * 8 + row - 128) * 256 + kh * 64 + ch * 8); }
            *(u32x4*)(Ks + row * 72 + ch * 8) = w;
        }
#pragma unroll
        for (int i = 0; i < 3; ++i) {
            const int key = lane + 64 * i, dc = wave;
            if (key < 160) {
                u32x4 w = (u32x4){0u, 0u, 0u, 0u};
                if (!samp) { const int kp = q0 - 128 + key; if (kp >= 0) w = *(const u32x4*)(Vb + (size_t)kp * 256 + kh * 64 + dc * 8); }
                else { if (key < 128) w = ld8_f32_as_bf16(cache_v + ((size_t)(b * 128 + key) * 4 + kh) * 64 + dc * 8);
                       else if (key < 136) w = *(const u32x4*)(Vb + (size_t)(TP + b * 8 + key - 128) * 256 + kh * 64 + dc * 8); }
                bf16_t* vp = Vt + (dc * 8) * 200 + key;
                vp[0 * 200] = (bf16_t)(w.x & 0xffff); vp[1 * 200] = (bf16_t)(w.x >> 16); vp[2 * 200] = (bf16_t)(w.y & 0xffff); vp[3 * 200] = (bf16_t)(w.y >> 16);
                vp[4 * 200] = (bf16_t)(w.z & 0xffff); vp[5 * 200] = (bf16_t)(w.z >> 16); vp[6 * 200] = (bf16_t)(w.w & 0xffff); vp[7 * 200] = (bf16_t)(w.w >> 16);
            }
        }
        __syncthreads();
        if (wave < (samp ? 2 : 8)) {
            int g, rowg, qrel;
            if (!samp) { g = wave >> 1; qrel = q0 + 16 * (wave & 1) + fr; rowg = qrel; }
            else { const int r = 16 * wave + fr; g = r >> 3; qrel = r & 7; rowg = TP + b * 8 + qrel; }
            const int head = kh * 4 + g;
            const bf16_t* qp = Qr + (size_t)rowg * 1024 + head * 64 + fq * 8;
            const bf16x8 qf0 = *(const bf16x8*)qp, qf1 = *(const bf16x8*)(qp + 32);
            f32x4 s[10];
#pragma unroll
            for (int f = 0; f < 10; ++f) {
                const bf16x8 k0 = *(const bf16x8*)(Ks + (16 * f + fr) * 72 + fq * 8), k1 = *(const bf16x8*)(Ks + (16 * f + fr) * 72 + 32 + fq * 8);
                f32x4 a = (f32x4){0.f, 0.f, 0.f, 0.f};
                a = __builtin_amdgcn_mfma_f32_16x16x32_bf16(k0, qf0, a, 0, 0, 0);
                a = __builtin_amdgcn_mfma_f32_16x16x32_bf16(k1, qf1, a, 0, 0, 0);
                s[f] = a;
            }
            const float sink = sinks[head];
            float mx = sink;
#pragma unroll
            for (int f = 0; f < 10; ++f)
#pragma unroll
                for (int j = 0; j < 4; ++j) {
                    const int idx = 16 * f + 4 * fq + j; bool valid;
                    if (!samp) { const int kp = q0 - 128 + idx; valid = (kp >= 0) && (kp <= qrel) && (qrel - kp < 128); }
                    else { valid = idx < 128 ? (idx > qrel) : (idx - 128 <= qrel); }
                    const float v = valid ? s[f][j] : -INFINITY; s[f][j] = v; mx = fmaxf(mx, v);
                }
            mx = fmaxf(mx, __shfl_xor(mx, 16)); mx = fmaxf(mx, __shfl_xor(mx, 32));
            float sum = 0.f;
#pragma unroll
            for (int f = 0; f < 10; ++f)
#pragma unroll
                for (int j = 0; j < 4; ++j) { const float e = __expf(s[f][j] - mx); s[f][j] = e; sum += e; }
            sum += __shfl_xor(sum, 16); sum += __shfl_xor(sum, 32);
            const float inv = 1.0f / (sum + __expf(sink - mx));
            f32x4 o[4];
#pragma unroll
            for (int d = 0; d < 4; ++d) o[d] = (f32x4){0.f, 0.f, 0.f, 0.f};
#pragma unroll
            for (int st = 0; st < 5; ++st) {
                u32x4 pw; pw.x = cvt_pk_bf16(s[2 * st][0], s[2 * st][1]); pw.y = cvt_pk_bf16(s[2 * st][2], s[2 * st][3]);
                pw.z = cvt_pk_bf16(s[2 * st + 1][0], s[2 * st + 1][1]); pw.w = cvt_pk_bf16(s[2 * st + 1][2], s[2 * st + 1][3]);
                bf16x8 pf; __builtin_memcpy(&pf, &pw, 16);
#pragma unroll
                for (int d = 0; d < 4; ++d) {
                    const bf16_t* vp = Vt + (16 * d + fr) * 200 + 32 * st + 4 * fq;
                    const u32x2 v0 = *(const u32x2*)vp, v1 = *(const u32x2*)(vp + 16);
                    u32x4 vw; vw.x = v0.x; vw.y = v0.y; vw.z = v1.x; vw.w = v1.y;
                    bf16x8 vf; __builtin_memcpy(&vf, &vw, 16);
                    o[d] = __builtin_amdgcn_mfma_f32_16x16x32_bf16(vf, pf, o[d], 0, 0, 0);
                }
            }
#pragma unroll
            for (int d = 0; d < 4; ++d) { u32x2 w; w.x = cvt_pk_bf16(o[d][0] * inv, o[d][1] * inv); w.y = cvt_pk_bf16(o[d][2] * inv, o[d][3] * inv);
                *(u32x2*)(Ob + (size_t)rowg * 1024 + head * 64 + 16 * d + 4 * fq) = w; }
        }
    }
    const size_t gt = (size_t)obid() * blockDim.x + otid(), gs = (size_t)gridDim.x * blockDim.x;
    for (size_t i = gt; i < (size_t)2 * 983040; i += gs) {
        const int which = i >= 983040; const size_t j = which ? i - 983040 : i; const size_t bb = j / 7680, rem = j % 7680;
        const float* src = (which ? cache_v : cache_k) + (bb * 8192 + 512 + rem) * 4;
        *(f32x4*)(P.out + (which ? OUT_VS : OUT_KS) + (bb * 8192 + rem) * 4) = *(const f32x4*)src;
    }
}

template <bool TA, bool TB>
__device__ __forceinline__ void tile_mm(f32x4 (&acc)[4][2], const bf16_t* A, int lda, const bf16_t* B, int ldb, int K, unsigned char* lds) {
    bf16_t* As = (bf16_t*)lds; bf16_t* Bs = As + 128 * 72;
    const int tid = otid(), wave = tid >> 6, lane = tid & 63, wr = wave >> 2, wc = wave & 3, fr = lane & 15, fq = lane >> 4;
    u32x4 ra[2], rb[2];
#define TM_LOAD(k0) do { _Pragma("unroll") for (int i_ = 0; i_ < 2; ++i_) { const int c_ = tid + 512 * i_; \
        if (!TA) ra[i_] = *(const u32x4*)(A + (size_t)(c_ >> 3) * lda + (k0) + (c_ & 7) * 8); else ra[i_] = *(const u32x4*)(A + (size_t)((k0) + (c_ & 63)) * lda + (c_ >> 6) * 8); \
        if (!TB) rb[i_] = *(const u32x4*)(B + (size_t)(c_ >> 3) * ldb + (k0) + (c_ & 7) * 8); else rb[i_] = *(const u32x4*)(B + (size_t)((k0) + (c_ & 63)) * ldb + (c_ >> 6) * 8); } } while (0)
#define TM_ST1(S, r, T) do { _Pragma("unroll") for (int i_ = 0; i_ < 2; ++i_) { const int c_ = tid + 512 * i_; \
        if (!T) *(u32x4*)(S + (c_ >> 3) * 72 + (c_ & 7) * 8) = r[i_]; \
        else { bf16_t* p_ = S + ((c_ >> 6) * 8) * 72 + (c_ & 63); const u32x4 w_ = r[i_]; \
            p_[0] = (bf16_t)(w_.x & 0xffff); p_[72] = (bf16_t)(w_.x >> 16); p_[144] = (bf16_t)(w_.y & 0xffff); p_[216] = (bf16_t)(w_.y >> 16); \
            p_[288] = (bf16_t)(w_.z & 0xffff); p_[360] = (bf16_t)(w_.z >> 16); p_[432] = (bf16_t)(w_.w & 0xffff); p_[504] = (bf16_t)(w_.w >> 16); } } } while (0)
    TM_LOAD(0);
    for (int k0 = 0; k0 < K; k0 += 64) {
        __syncthreads();
        TM_ST1(As, ra, TA); TM_ST1(Bs, rb, TB);
        __syncthreads();
        if (k0 + 64 < K) TM_LOAD(k0 + 64);
#pragma unroll
        for (int ks = 0; ks < 2; ++ks) {
            bf16x8 af[4], bfr[2];
#pragma unroll
            for (int m = 0; m < 4; ++m) af[m] = *(const bf16x8*)(As + (64 * wr + 16 * m + fr) * 72 + ks * 32 + fq * 8);
#pragma unroll
            for (int n = 0; n < 2; ++n) bfr[n] = *(const bf16x8*)(Bs + (32 * wc + 16 * n + fr) * 72 + ks * 32 + fq * 8);
#pragma unroll
            for (int m = 0; m < 4; ++m)
#pragma unroll
                for (int n = 0; n < 2; ++n) acc[m][n] = __builtin_amdgcn_mfma_f32_16x16x32_bf16(bfr[n], af[m], acc[m][n], 0, 0, 0);
        }
    }
#undef TM_LOAD
#undef TM_ST1
}
#define ZERO_ACC(acc) do { _Pragma("unroll") for (int m_ = 0; m_ < 4; ++m_) _Pragma("unroll") for (int n_ = 0; n_ < 2; ++n_) acc[m_][n_] = (f32x4){0.f, 0.f, 0.f, 0.f}; } while (0)

__device__ void ret_phase_a(const Params& P, unsigned char* lds) {
    unsigned char* ws = P.ws;
    const bf16_t* RQ = (const bf16_t*)(ws + WS_RQ); const bf16_t* RKZ = (const bf16_t*)(ws + WS_RKZ); const bf16_t* RV = (const bf16_t*)(ws + WS_RV);
    bf16_t* ATT = (bf16_t*)(ws + WS_ATT); float* U = (float*)(ws + WS_U); float* ORET = (float*)(ws + WS_ORET);
    const int tid = otid(), wave = tid >> 6, lane = tid & 63, wr = wave >> 2, wc = wave & 3, fr = lane & 15, fq = lane >> 4;
    for (int it = obid(); it < 512; it += gridDim.x) {
        const int c = it >> 2, h = it & 3; const float lg = lg2gamma(h);
        f32x4 acc[4][2]; ZERO_ACC(acc);
        tile_mm<false, false>(acc, RQ + (size_t)c * 128 * 1024 + h * 256, 1024, RKZ + (size_t)c * 128 * 1024 + h * 256, 1024, 256, lds);
#pragma unroll
        for (int m = 0; m < 4; ++m) { const int i = 64 * wr + 16 * m + fr; const float sc = exp2f((float)(i - 127) * lg);
#pragma unroll
            for (int n = 0; n < 2; ++n) { const int j = 32 * wc + 16 * n + 4 * fq; const f32x4 v = acc[m][n];
                u32x2 w; w.x = cvt_pk_bf16(j <= i ? v[0] * sc : 0.f, j + 1 <= i ? v[1] * sc : 0.f); w.y = cvt_pk_bf16(j + 2 <= i ? v[2] * sc : 0.f, j + 3 <= i ? v[3] * sc : 0.f);
                *(u32x2*)(ATT + (size_t)it * 16384 + i * 128 + j) = w; } }
    }
    for (int it = obid(); it < 4096; it += gridDim.x) {
        const int dkt = it & 1, dvt = (it >> 1) & 3, ch = it >> 3, c = ch >> 2, h = ch & 3;
        f32x4 acc[4][2]; ZERO_ACC(acc);
        tile_mm<true, true>(acc, RV + (size_t)c * 128 * 2048 + h * 512 + dvt * 128, 2048, RKZ + (size_t)c * 128 * 1024 + h * 256 + dkt * 128, 1024, 128, lds);
        float* base = U + ((size_t)ch * 512 + dvt * 128) * 256 + dkt * 128;
#pragma unroll
        for (int m = 0; m < 4; ++m)
#pragma unroll
            for (int n = 0; n < 2; ++n) *(f32x4*)(base + (size_t)(64 * wr + 16 * m + fr) * 256 + 32 * wc + 16 * n + 4 * fq) = acc[m][n];
    }
    float* qs = (float*)lds;
    float* kzs = (float*)(lds + 8192);
    float* Amat = (float*)(lds + 16384);
    float* part = (float*)(lds + 32768);
    const float* S0 = P.in[4]; float* SN = P.out + OUT_SS;
    for (int it = obid(); it < 512; it += gridDim.x) {
        const int b = it >> 2, h = it & 3; const float lg = lg2gamma(h);
        __syncthreads();
        { const int t = tid >> 6, d4 = (tid & 63) * 4; const size_t off = (size_t)(TP + b * 8 + t) * 1024 + h * 256 + d4;
          const u32x2 qw = *(const u32x2*)(RQ + off), kw = *(const u32x2*)(RKZ + off);
          qs[(d4 + 0) * 8 + t] = bflo(qw.x); qs[(d4 + 1) * 8 + t] = bfhi(qw.x); qs[(d4 + 2) * 8 + t] = bflo(qw.y); qs[(d4 + 3) * 8 + t] = bfhi(qw.y);
          kzs[(d4 + 0) * 8 + t] = bflo(kw.x); kzs[(d4 + 1) * 8 + t] = bfhi(kw.x); kzs[(d4 + 2) * 8 + t] = bflo(kw.y); kzs[(d4 + 3) * 8 + t] = bfhi(kw.y); }
        __syncthreads();
        { const int p = tid >> 3, pt = tid & 7, i = p >> 3, j = p & 7; float s = 0.f;
          for (int d = pt * 32; d < pt * 32 + 32; ++d) s += qs[d * 8 + i] * kzs[d * 8 + j];
          s += __shfl_xor(s, 1); s += __shfl_xor(s, 2); s += __shfl_xor(s, 4);
          if (pt == 0) Amat[p] = (j <= i) ? s * exp2f((float)(i - 7) * lg) : 0.f; }
        const int e4 = tid & 127, dg = tid >> 7;
        f32x4 vv[8];
#pragma unroll
        for (int j = 0; j < 8; ++j) { const u32x2 w = *(const u32x2*)(RV + (size_t)(TP + b * 8 + j) * 2048 + h * 512 + e4 * 4); vv[j] = (f32x4){bflo(w.x), bfhi(w.x), bflo(w.y), bfhi(w.y)}; }
        f32x4 oacc[8];
#pragma unroll
        for (int i = 0; i < 8; ++i) oacc[i] = (f32x4){0.f, 0.f, 0.f, 0.f};
        const float g8 = exp2f(8.0f * lg);
        const size_t sbase = (size_t)it * 131072 + e4 * 4;
#pragma unroll 4
        for (int d = dg * 64; d < dg * 64 + 64; ++d) {
            const f32x4 Sv = *(const f32x4*)(S0 + sbase + (size_t)d * 512);
            const f32x4 q0 = *(const f32x4*)(qs + d * 8), q1 = *(const f32x4*)(qs + d * 8 + 4), k0 = *(const f32x4*)(kzs + d * 8), k1 = *(const f32x4*)(kzs + d * 8 + 4);
            oacc[0] += Sv * q0[0]; oacc[1] += Sv * q0[1]; oacc[2] += Sv * q0[2]; oacc[3] += Sv * q0[3];
            oacc[4] += Sv * q1[0]; oacc[5] += Sv * q1[1]; oacc[6] += Sv * q1[2]; oacc[7] += Sv * q1[3];
            f32x4 sn = Sv * g8;
            sn += vv[0] * k0[0]; sn += vv[1] * k0[1]; sn += vv[2] * k0[2]; sn += vv[3] * k0[3];
            sn += vv[4] * k1[0]; sn += vv[5] * k1[1]; sn += vv[6] * k1[2]; sn += vv[7] * k1[3];
            *(f32x4*)(SN + sbase + (size_t)d * 512) = sn;
        }
#pragma unroll
        for (int i = 0; i < 8; ++i) *(f32x4*)(part + (dg * 8 + i) * 512 + e4 * 4) = oacc[i];
        __syncthreads();
#pragma unroll
        for (int ii = 0; ii < 2; ++ii) { const int i = dg * 2 + ii;
            f32x4 tot = *(const f32x4*)(part + (0 * 8 + i) * 512 + e4 * 4); tot += *(const f32x4*)(part + (1 * 8 + i) * 512 + e4 * 4);
            tot += *(const f32x4*)(part + (2 * 8 + i) * 512 + e4 * 4); tot += *(const f32x4*)(part + (3 * 8 + i) * 512 + e4 * 4);
            f32x4 o = tot * exp2f((float)(i + 1) * lg);
#pragma unroll
            for (int j = 0; j < 8; ++j) o += vv[j] * Amat[i * 8 + j];
            *(f32x4*)(ORET + (size_t)(TP + b * 8 + i) * 2048 + h * 512 + e4 * 4) = o; }
    }
}
__device__ void ret_phase_b(const Params& P) {
    const float* U = (const float*)(P.ws + WS_U); bf16_t* SB = (bf16_t*)(P.ws + WS_SB);
    for (size_t e4 = (size_t)obid() * blockDim.x + otid(); e4 < 131072; e4 += (size_t)gridDim.x * blockDim.x) {
        const size_t idx = e4 * 4; const int h = (int)(idx >> 17); const float a = exp2f(128.0f * lg2gamma(h));
        f32x4 s = (f32x4){0.f, 0.f, 0.f, 0.f};
#pragma unroll 8
        for (int c = 0; c < 128; ++c) {
            u32x2 w; w.x = cvt_pk_bf16(s[0], s[1]); w.y = cvt_pk_bf16(s[2], s[3]);
            *(u32x2*)(SB + (size_t)c * 524288 + idx) = w;
            const f32x4 u = *(const f32x4*)(U + (size_t)c * 524288 + idx);
            s = s * a + u;
        }
        const int rem = (int)(idx & 131071), dv = rem >> 8, dk = rem & 255;
        float* o = P.out + OUT_SP + (size_t)h * 131072 + (size_t)dk * 512 + dv;
        o[0] = s[0]; o[512] = s[1]; o[1024] = s[2]; o[1536] = s[3];
    }
}
__device__ void ret_phase_c(const Params& P, unsigned char* lds) {
    unsigned char* ws = P.ws;
    const bf16_t* RQ = (const bf16_t*)(ws + WS_RQ); const bf16_t* RV = (const bf16_t*)(ws + WS_RV); const bf16_t* ATT = (const bf16_t*)(ws + WS_ATT); const bf16_t* SB = (const bf16_t*)(ws + WS_SB);
    float* ORET = (float*)(ws + WS_ORET);
    const int tid = otid(), wave = tid >> 6, lane = tid & 63, wr = wave >> 2, wc = wave & 3, fr = lane & 15, fq = lane >> 4;
    for (int it = obid(); it < 2048; it += gridDim.x) {
        const int dvt = it & 3, ch = it >> 2, c = ch >> 2, h = ch & 3; const float lg = lg2gamma(h);
        f32x4 acc[4][2]; ZERO_ACC(acc);
        tile_mm<false, false>(acc, RQ + (size_t)c * 128 * 1024 + h * 256, 1024, SB + ((size_t)ch * 512 + dvt * 128) * 256, 256, 256, lds);
#pragma unroll
        for (int m = 0; m < 4; ++m) { const float xi = exp2f((float)(64 * wr + 16 * m + fr + 1) * lg); acc[m][0] *= xi; acc[m][1] *= xi; }
        tile_mm<false, true>(acc, ATT + (size_t)ch * 16384, 128, RV + (size_t)c * 128 * 2048 + h * 512 + dvt * 128, 2048, 128, lds);
        float* base = ORET + (size_t)c * 128 * 2048 + h * 512 + dvt * 128;
#pragma unroll
        for (int m = 0; m < 4; ++m)
#pragma unroll
            for (int n = 0; n < 2; ++n) *(f32x4*)(base + (size_t)(64 * wr + 16 * m + fr) * 2048 + 32 * wc + 16 * n + 4 * fq) = acc[m][n];
    }
}
__device__ void ret_phase_d(const Params& P) {
    const float* ORET = (const float*)(P.ws + WS_ORET); const bf16_t* RG = (const bf16_t*)(P.ws + WS_RG); bf16_t* YB = (bf16_t*)(P.ws + WS_YB);
    const int wave = otid() >> 6, lane = otid() & 63;
    for (int r = obid() * 8 + wave; r < MT * 4; r += gridDim.x * 8) {
        const size_t off = (size_t)(r >> 2) * 2048 + (r & 3) * 512 + 4 * lane;
        f32x4 a = *(const f32x4*)(ORET + off), b = *(const f32x4*)(ORET + off + 256);
        const float mu = wave_sum((a[0] + a[1]) + (a[2] + a[3]) + (b[0] + b[1]) + (b[2] + b[3])) * (1.0f / 512.0f);
        a -= mu; b -= mu;
        const float rstd = rsqrtf(wave_sum((a[0] * a[0] + a[1] * a[1]) + (a[2] * a[2] + a[3] * a[3]) + (b[0] * b[0] + b[1] * b[1]) + (b[2] * b[2] + b[3] * b[3])) * (1.0f / 512.0f) + LN_EPS);
        const u32x2 ga = *(const u32x2*)(RG + off), gb = *(const u32x2*)(RG + off + 256);
        u32x2 w; w.x = cvt_pk_bf16(a[0] * rstd * bflo(ga.x), a[1] * rstd * bfhi(ga.x)); w.y = cvt_pk_bf16(a[2] * rstd * bflo(ga.y), a[3] * rstd * bfhi(ga.y));
        *(u32x2*)(YB + off) = w;
        w.x = cvt_pk_bf16(b[0] * rstd * bflo(gb.x), b[1] * rstd * bfhi(gb.x)); w.y = cvt_pk_bf16(b[2] * rstd * bflo(gb.y), b[3] * rstd * bfhi(gb.y));
        *(u32x2*)(YB + off + 256) = w;
    }
}

__global__ void __launch_bounds__(512, 2) fwd_kernel(Params P) {
    extern __shared__ __attribute__((aligned(16))) unsigned char lds[];
    cg::grid_group grid = cg::this_grid();
    PG8_LAS unsigned char* l3 = (PG8_LAS unsigned char*)lds;
    for (int ph = P.lo; ph < P.hi; ++ph) {
        if (ph > P.lo) grid.sync();
        unsigned char* ws = P.ws; asm volatile("" : "+s"(ws));
        float* XF = (float*)(ws + WS_XF); bf16_t* XB = (bf16_t*)(ws + WS_XB); float* Z = (float*)(ws + WS_Z); bf16_t* H = (bf16_t*)(ws + WS_H);
        int kind, l = 0, f = 0, lnw = 0;
        if (ph == 0) kind = 0;
        else {
            l = ph > 10 ? 1 : 0; const int q = ph - 1 - 10 * l;
            if (l == 0) { kind = q == 0 ? 1 : q == 1 ? 2 : q == 2 ? 3 : q == 3 ? 4 : q == 4 ? 5 : q == 5 ? 6 : q == 6 ? 3 : q == 7 ? 1 : q == 8 ? 2 : 3;
                f = q >= 7 ? 1 : 0; lnw = q == 2 ? 0 : q == 6 ? 1 : 2; }
            else { kind = q == 0 ? 1 : q == 1 ? 2 : q == 2 ? 3 : q == 3 ? 7 : q == 4 ? 8 : q == 5 ? 9 : q == 6 ? 10 : q == 7 ? 11 : q == 8 ? 12 : q == 9 ? 3 : q == 10 ? 1 : q == 11 ? 2 : 3;
                f = q >= 10 ? 1 : 0; lnw = q == 2 ? 0 : q == 9 ? 1 : 2; }
        }
#ifndef PH_MASK
#define PH_MASK 0xffff
#endif
#define PHON(k) ((PH_MASK >> (k)) & 1)
        if (kind == 0) { if (PHON(0)) phase0(P, lds); }
        else if (kind == 1 && PHON(1)) {
            pg8::Gemm g{XB, (const bf16_t*)(ws + WS_WGU + (size_t)(l * 2 + f) * SZ_WGU), MT, 2 * FF, DM}; pg8::StaticOrder S; S.init(MT, 2 * FF, gridDim.x, obid());
            EpiSwiGLU E{H}; pg8::gemm_phase<EpiSwiGLU, pg8::StaticOrder, false>(l3, g, S, E, nullptr);
        } else if ((kind == 2 || kind == 6 || kind == 12) && PHON(2)) {
            const bf16_t* A; const bf16_t* Bt; int K; float sc;
            if (kind == 2) { A = H; Bt = (const bf16_t*)(ws + WS_WD + (size_t)(l * 2 + f) * SZ_WD); K = FF; sc = 0.5f; }
            else if (kind == 6) { A = (const bf16_t*)(ws + WS_OB); Bt = (const bf16_t*)(ws + WS_WO); K = DM; sc = 1.0f; }
            else { A = (const bf16_t*)(ws + WS_YB); Bt = (const bf16_t*)(ws + WS_WRO); K = 2048; sc = 1.0f; }
            pg8::Gemm g{A, Bt, MT, DM, K}; pg8::StaticOrder S; S.init(MT, DM, gridDim.x, obid());
            EpiResid E{XF, Z, sc}; pg8::gemm_phase<EpiResid, pg8::StaticOrder, false>(l3, g, S, E, nullptr);
        } else if (kind == 3 && PHON(3)) {
            const bool fin = (ph == NPH - 1);
            ln_phase(Z, P.in[11] + (size_t)(l * 3 + lnw) * DM, P.in[12] + (size_t)(l * 3 + lnw) * DM, fin ? P.out + OUT_Y : XF, XB);
        } else if (kind == 4 && PHON(4)) {
            pg8::Gemm g{XB, (const bf16_t*)(ws + WS_WQKV), MT, NQKV, DM}; pg8::StaticOrder S; S.init(MT, NQKV, gridDim.x, obid());
            EpiQKV E{(bf16_t*)(ws + WS_QR), (bf16_t*)(ws + WS_KR), (bf16_t*)(ws + WS_VB), (const float*)(ws + WS_ROPEA), P.out};
            pg8::gemm_phase<EpiQKV, pg8::StaticOrder, false>(l3, g, S, E, nullptr);
        } else if (kind == 5 && PHON(5)) attn_phase(P, lds);
        else if (kind == 7 && PHON(7)) {
            pg8::Gemm g{XB, (const bf16_t*)(ws + WS_WRIN), MT, NRIN, DM}; pg8::StaticOrder S; S.init(MT, NRIN, gridDim.x, obid());
            EpiRet E{(bf16_t*)(ws + WS_RQ), (bf16_t*)(ws + WS_RKZ), (bf16_t*)(ws + WS_RV), (bf16_t*)(ws + WS_RG), (const float*)(ws + WS_ROPER)};
            pg8::gemm_phase<EpiRet, pg8::StaticOrder, false>(l3, g, S, E, nullptr);
        } else if (kind == 8 && PHON(8)) ret_phase_a(P, lds);
        else if (kind == 9 && PHON(9)) ret_phase_b(P);
        else if (kind == 10 && PHON(10)) ret_phase_c(P, lds);
        else if (kind == 11 && PHON(11)) ret_phase_d(P);
        __syncthreads();
    }
}

extern "C" void kernel_launch(void* const* d_in, const int* in_sizes, int n_in, void* d_out, int out_size, void* d_ws, size_t ws_size, hipStream_t stream) {
    static int grid = 0;
    if (grid == 0) {
        if (n_in != 18 || (size_t)out_size != OUT_END || ws_size < WS_END) { fprintf(stderr, "kernel_launch: unexpected shapes: n_in %d out %d ws %zu (need %zu)\n", n_in, out_size, ws_size, (size_t)WS_END); grid = -1; return; }
        int dev = 0, cus = 0, per_cu = 0;
        hipGetDevice(&dev); hipDeviceGetAttribute(&cus, hipDeviceAttributeMultiprocessorCount, dev);
        if (hipFuncSetAttribute((const void*)fwd_kernel, hipFuncAttributeMaxDynamicSharedMemorySize, LDS_BYTES) != hipSuccess) { fprintf(stderr, "kernel_launch: hipFuncSetAttribute failed\n"); grid = -1; return; }
        if (hipOccupancyMaxActiveBlocksPerMultiprocessor(&per_cu, (const void*)fwd_kernel, 512, LDS_BYTES) != hipSuccess || per_cu < 1) { fprintf(stderr, "kernel_launch: occupancy query says %d\n", per_cu); per_cu = 1; }
        (void)hipGetLastError();
        grid = cus;
    }
    if (grid < 0) return;
    Params p{};
    for (int i = 0; i < 18; ++i) p.in[i] = (const float*)d_in[i];
    p.out = (float*)d_out; p.ws = (unsigned char*)d_ws;
#if ONE_LAUNCH
    p.lo = 0; p.hi = NPH;
    { void* args[] = {&p}; hipError_t e = hipLaunchCooperativeKernel((const void*)fwd_kernel, dim3(grid), dim3(512), args, LDS_BYTES, stream);
      if (e != hipSuccess) fprintf(stderr, "cooperative launch failed: %s (grid %d)\n", hipGetErrorString(e), grid); }
#else
    for (int ph = 0; ph < NPH; ++ph) { p.lo = ph; p.hi = ph + 1; void* args[] = {&p};
        hipError_t e = hipLaunchCooperativeKernel((const void*)fwd_kernel, dim3(grid), dim3(512), args, LDS_BYTES, stream);
        if (e != hipSuccess) { fprintf(stderr, "cooperative launch %d failed: %s (grid %d)\n", ph, hipGetErrorString(e), grid); break; } }
#endif
}
```

```cpp
#include <hip/hip_runtime.h>
#include <hip/hip_cooperative_groups.h>
#include <cstdio>
namespace cg = cooperative_groups;
#ifndef ONE_LAUNCH
#define ONE_LAUNCH 1
#endif
__device__ __forceinline__ int otid() { int t = threadIdx.x; asm volatile("" : "+v"(t)); return t; }
__device__ __forceinline__ int obid() { int t = blockIdx.x; asm volatile("" : "+s"(t)); return t; }
namespace pg8 {
#define PG8_LAS __attribute__((address_space(3)))
typedef unsigned short bf16_t;
typedef short bf16x8 __attribute__((ext_vector_type(8)));
typedef float f32x4 __attribute__((ext_vector_type(4)));
typedef unsigned u32x4 __attribute__((ext_vector_type(4)));
constexpr int BM = 256, BK = 64, HALF = 128, HTB = HALF * BK * 2  , STAGE_BYTES = 8 * HTB, NXCD = 8, WGM = 8;

__host__ __device__ __forceinline__ int lds_byte(int r, int c) { const int st = (r >> 4) * 2 + (c >> 5), rr = r & 15, cc = c & 31, ob = rr * 64 + cc * 2; return st * 1024 + (ob ^ (((ob >> 9) & 1) << 5)); }
__host__ __device__ __forceinline__ void stage_rc(int b, int& R, int& C) { const int st = b / 1024, sb = b % 1024, swz = sb ^ (((sb >> 9) & 1) << 5); R = (st >> 1) * 16 + swz / 64; C = (st & 1) * 32 + (swz % 64) / 2; }
__host__ __device__ __forceinline__ int perm32(int rho) { const int n = rho >> 4, i = rho & 15; return 8 * (i >> 2) + 4 * n + (i & 3); }

struct Unit { int pm, pn; };
struct Gemm { const bf16_t* A; const bf16_t* Bt; int M, N, K; };

struct StaticOrder {
    int nM, nN, nwg, G, c;
    __host__ __device__ void init(int M, int N, int G_, int c_) { nM = M / BM; nN = N / BM; nwg = nM * nN; G = G_; c = c_; }
    __host__ __device__ bool next(int i, Unit& u) const {
        const long L = (long)i * G + c; if (L >= nwg) return false;
        int wgid = (int)L; { const int q = nwg / NXCD, r = nwg % NXCD, xcd = wgid % NXCD, off = wgid / NXCD; wgid = (xcd < r ? xcd * (q + 1) : r * (q + 1) + (xcd - r) * q) + off; }
        const int nig = WGM * nN, gid = wgid / nig, fm = gid * WGM, gsz = (nM - fm) < WGM ? (nM - fm) : WGM;
        u.pm = fm + ((wgid % nig) % gsz); u.pn = (wgid % nig) / gsz; return true;
    }
    __device__ __forceinline__ void a_ready(const Unit&) const {}
    __device__ __forceinline__ void done(const Unit&) const {}
};
struct CountedOrder : StaticOrder {
    const unsigned* ready; unsigned need; unsigned* tmo;
    __device__ __forceinline__ void a_ready(const Unit& u) const {
        if (threadIdx.x < 64) {
            const unsigned long long t0 = __builtin_amdgcn_s_memrealtime(); unsigned polls = 0;
            while ((unsigned)__builtin_amdgcn_readfirstlane(__hip_atomic_load(ready + 64 * u.pm, __ATOMIC_RELAXED, __HIP_MEMORY_SCOPE_AGENT)) < need) {
                if ((++polls & 255u) == 0u && __builtin_amdgcn_readfirstlane(__hip_atomic_load(tmo, __ATOMIC_RELAXED, __HIP_MEMORY_SCOPE_AGENT)) != 0u) break;
                if (__builtin_amdgcn_s_memrealtime() - t0 > 2000000ull) {
                    if (threadIdx.x == 0) { unsigned expect = 0u; __hip_atomic_compare_exchange_strong(tmo + 1, &expect, 0x600u | (unsigned)(u.pm & 0xff), __ATOMIC_RELAXED, __ATOMIC_RELAXED, __HIP_MEMORY_SCOPE_AGENT); __hip_atomic_store(tmo, 1u, __ATOMIC_RELAXED, __HIP_MEMORY_SCOPE_AGENT); }
                    break; }
                __builtin_amdgcn_s_sleep(2); }
            __builtin_amdgcn_fence(__ATOMIC_ACQUIRE, "agent");
            asm volatile("s_waitcnt vmcnt(0)" ::: "memory");
        }
#if !defined(BROKEN_HOOK_NO_BARRIER)
        asm volatile("" ::: "memory"); __builtin_amdgcn_s_barrier(); asm volatile("" ::: "memory");
#endif
    }
};

__device__ __forceinline__ unsigned cvt_pk_bf16(float lo, float hi) { unsigned r; asm volatile("v_cvt_pk_bf16_f32 %0, %1, %2" : "=v"(r) : "v"(lo), "v"(hi)); return r; }
typedef float f32x2 __attribute__((ext_vector_type(2)));
__device__ __forceinline__ f32x2 gelu_pk(f32x2 v) {
    const f32x2 av = __builtin_elementwise_abs(v), d = av * 0.2316418882f + 1.0f;
    f32x2 t; t.x = __builtin_amdgcn_rcpf(d.x); t.y = __builtin_amdgcn_rcpf(d.y);
    f32x2 q = t * 0.5307027145f + (-0.7265760135f); q = q * t + 0.7107068705f; q = q * t + (-0.142248368f); q = q * t + 0.127414796f; q = q * t;
    const f32x2 s = (v * v) * (-0.72134752044f);
    f32x2 e; e.x = __builtin_amdgcn_exp2f(s.x); e.y = __builtin_amdgcn_exp2f(s.y);
    const f32x2 m = v * (q * e), r = v - m;
    f32x2 o; o.x = v.x < 0.f ? m.x : r.x; o.y = v.y < 0.f ? m.y : r.y; return o;
}

struct PanelStats {
    unsigned* xbuf;
    unsigned* cnt;
    unsigned* tmo;
    int ntn; float eps;
    unsigned code;
    __device__ __forceinline__ bool run(const f32x4 (&v)[2][2][4][2], const Unit& u, int wr, int wc, int fr, int fq, PG8_LAS unsigned char* lds, int wid, int lane) const {
        typedef float f32x2v __attribute__((ext_vector_type(2)));
        PG8_LAS f32x2v* P = (PG8_LAS f32x2v*)lds;
        PG8_LAS f32x2v* S = (PG8_LAS f32x2v*)(lds + 8192);
        PG8_LAS unsigned* flag = (PG8_LAS unsigned*)(lds + 8192 + 2048);
#pragma unroll
        for (int ai = 0; ai < 2; ++ai)
#pragma unroll
            for (int m = 0; m < 4; ++m) {
                float s = 0.f;
#pragma unroll
                for (int bj = 0; bj < 2; ++bj)
#pragma unroll
                    for (int n = 0; n < 2; ++n) { const f32x4 x = v[ai][bj][m][n]; s += (x[0] + x[1]) + (x[2] + x[3]); }
                s += __shfl_xor(s, 16); s += __shfl_xor(s, 32);
                const float mw = s * (1.0f / 64.0f); float q = 0.f;
#pragma unroll
                for (int bj = 0; bj < 2; ++bj)
#pragma unroll
                    for (int n = 0; n < 2; ++n) { const f32x4 d = v[ai][bj][m][n] - mw; q += (d[0] * d[0] + d[1] * d[1]) + (d[2] * d[2] + d[3] * d[3]); }
                q += __shfl_xor(q, 16); q += __shfl_xor(q, 32);
                if (fq == 0) P[(ai * HALF + wr * 64 + m * 16 + fr) * 4 + wc] = (f32x2v){mw, q};
            }
        asm volatile("s_waitcnt lgkmcnt(0)" ::: "memory"); __builtin_amdgcn_s_barrier(); asm volatile("" ::: "memory");
#if defined(BROKEN_NO_WAIT)
        if (blockIdx.x >= 64) { const long long t0 = clock64(); while (clock64() - t0 < 60000) __builtin_amdgcn_s_sleep(8); }
#endif
        const int row = wid * 32 + (lane & 31);
        if (lane < 32) {
            const f32x2v a = P[row * 4 + 0], b = P[row * 4 + 1], c = P[row * 4 + 2], d = P[row * 4 + 3];
            const float mt = (a.x + b.x + c.x + d.x) * 0.25f;
            const float da = a.x - mt, db = b.x - mt, dc = c.x - mt, dd = d.x - mt;
            const float m2 = (a.y + b.y) + (c.y + d.y) + 64.0f * ((da * da + db * db) + (dc * dc + dd * dd));
            unsigned long long* slot = (unsigned long long*)xbuf + ((size_t)(u.pm * BM + row) * 4 + u.pn);
            __hip_atomic_store(slot, ((unsigned long long)__float_as_uint(m2) << 32) | __float_as_uint(mt), __ATOMIC_RELAXED, __HIP_MEMORY_SCOPE_AGENT);
        }
        asm volatile("s_waitcnt vmcnt(0)" ::: "memory");
        if (lane == 0) __hip_atomic_fetch_add(cnt + 64 * u.pm, 1u, __ATOMIC_RELAXED, __HIP_MEMORY_SCOPE_AGENT);
        if (wid == 0) {
            bool dead = false; const unsigned long long t0 = __builtin_amdgcn_s_memrealtime(); const unsigned want = 8u * (unsigned)ntn;
            for (;;) {
#if defined(BROKEN_NO_WAIT)
                break;
#endif
                if ((unsigned)__builtin_amdgcn_readfirstlane(__hip_atomic_load(cnt + 64 * u.pm, __ATOMIC_RELAXED, __HIP_MEMORY_SCOPE_AGENT)) >= want) break;
                if (__builtin_amdgcn_s_memrealtime() - t0 > 2000000ull) {
                    if (lane == 0) { unsigned expect = 0u; __hip_atomic_compare_exchange_strong(tmo + 1, &expect, code | (unsigned)(u.pm & 0xff), __ATOMIC_RELAXED, __ATOMIC_RELAXED, __HIP_MEMORY_SCOPE_AGENT);
                                     __hip_atomic_store(tmo, 1u, __ATOMIC_RELAXED, __HIP_MEMORY_SCOPE_AGENT); }
                    dead = true; break; }
                __builtin_amdgcn_s_sleep(2);
            }
            __builtin_amdgcn_fence(__ATOMIC_ACQUIRE, "agent");
            if (lane == 0) flag[0] = dead ? 1u : 0u;
        }
        asm volatile("s_waitcnt vmcnt(0) lgkmcnt(0)" ::: "memory"); __builtin_amdgcn_s_barrier(); asm volatile("" ::: "memory");
        const bool bad = flag[0] != 0u;
        if (lane < 32) {
            const unsigned long long* slot = (const unsigned long long*)xbuf + (size_t)(u.pm * BM + row) * 4; float mt[4], m2[4]; float ms = 0.f;
#pragma unroll
            for (int t = 0; t < 4; ++t) { if (t < ntn) { const unsigned long long w = __hip_atomic_load(slot + t, __ATOMIC_RELAXED, __HIP_MEMORY_SCOPE_AGENT); mt[t] = __uint_as_float((unsigned)w); m2[t] = __uint_as_float((unsigned)(w >> 32)); } else { mt[t] = 0.f; m2[t] = 0.f; } ms += mt[t]; }
            const float mean = ms / (float)ntn; float q = 0.f;
#pragma unroll
            for (int t = 0; t < 4; ++t) if (t < ntn) { const float dm = mt[t] - mean; q += m2[t] + 256.0f * dm * dm; }
            S[row] = (f32x2v){mean, 1.0f / sqrtf(q / (256.0f * (float)ntn) + eps)};
        }
        asm volatile("s_waitcnt lgkmcnt(0)" ::: "memory"); __builtin_amdgcn_s_barrier(); asm volatile("" ::: "memory");
        return bad;
    }
};
template <class Epi, class Sched, bool STAMP = false>
__device__ __forceinline__ void gemm_phase(PG8_LAS unsigned char* lds, const Gemm g, const Sched& S, const Epi& E, unsigned long long* stamps) {
    const int tid = otid(), wid = __builtin_amdgcn_readfirstlane(tid >> 6), lane = tid & 63, wr = wid >> 2, wc = wid & 3, fr = lane & 15, fq = lane >> 4;
    const int K = g.K, nt = K / BK;
    int ts_lo = 0, ts_hi = 0, nts = 0; const unsigned long long rt_entry = STAMP ? (unsigned long long)wall_clock64() : 0ull;
#define PG8_STAMP() do { if (STAMP && wid == 0 && nts < 64) { const unsigned long long _c = (unsigned long long)clock64(); \
        ts_lo = (lane == nts) ? (int)(unsigned)_c : ts_lo; ts_hi = (lane == nts) ? (int)(unsigned)(_c >> 32) : ts_hi; ++nts; } } while (0)
    PG8_STAMP();
    unsigned voffA[2], voffB[2];
#pragma unroll
    for (int i = 0; i < 2; ++i) { int R, C; stage_rc(tid * 16 + i * 8192, R, C); const int Rb = Epi::PERM ? ((R & ~31) + perm32(R & 31)) : R;
        voffA[i] = (unsigned)(R * K + C) * 2u; voffB[i] = (unsigned)(Rb * K + C) * 2u; }
    const size_t kstep = (size_t)(BK * 2);
    const size_t hstep = (size_t)HALF * K * 2;
    const size_t tstep = 2 * hstep;
    const unsigned ldsw = (unsigned)wid * 1024u;
    const int aoff = lds_byte(wr * 64 + fr, fq * 8), boff = lds_byte(wc * 32 + fr, fq * 8);
#define PG8_SA(b, h) (((b) * 2 + (h)) * HTB)
#define PG8_SB(b, h) ((4 + (b) * 2 + (h)) * HTB)
#define PG8_STAGE(bufoff, gbase, voff) do { _Pragma("unroll") for (int _i = 0; _i < 2; ++_i) \
        __builtin_amdgcn_global_load_lds((const unsigned*)((const char*)(gbase) + (voff)[_i]), (PG8_LAS unsigned*)(lds + (bufoff) + ldsw + _i * 8192), 16, 0, 0); } while (0)
#define PG8_LDA(dst, b, h) do { _Pragma("unroll") for (int m = 0; m < 4; ++m) _Pragma("unroll") for (int k = 0; k < 2; ++k) dst[m][k] = *(const PG8_LAS bf16x8*)(lds + PG8_SA(b, h) + aoff + m * 2048 + k * 1024); } while (0)
#define PG8_LDB(dst, b, h) do { _Pragma("unroll") for (int n = 0; n < 2; ++n) _Pragma("unroll") for (int k = 0; k < 2; ++k) dst[n][k] = *(const PG8_LAS bf16x8*)(lds + PG8_SB(b, h) + boff + n * 2048 + k * 1024); } while (0)
#define PG8_MMA(ai, bj, At, Bt) do { __builtin_amdgcn_s_setprio(1); _Pragma("unroll") for (int m = 0; m < 4; ++m) _Pragma("unroll") for (int n = 0; n < 2; ++n) _Pragma("unroll") for (int k = 0; k < 2; ++k) \
        acc[ai][bj][m][n] = __builtin_amdgcn_mfma_f32_16x16x32_bf16(Bt[n][k], At[m][k], acc[ai][bj][m][n], 0, 0, 0); __builtin_amdgcn_s_setprio(0); } while (0)
#define PG8_WAIT_V(n) asm volatile("s_waitcnt vmcnt(" #n ")" ::: "memory")
#define PG8_WAIT_L(n) asm volatile("s_waitcnt lgkmcnt(" #n ")" ::: "memory")
#define PG8_BAR __builtin_amdgcn_s_barrier()
#define PG8_SCHED __builtin_amdgcn_sched_barrier(0)
    Unit cur, nxt; int ui = 0;
    if (!S.next(0, cur)) return;
    f32x4 acc[2][2][4][2];
#pragma unroll
    for (int a = 0; a < 2; ++a)
#pragma unroll
        for (int b = 0; b < 2; ++b)
#pragma unroll
            for (int m = 0; m < 4; ++m)
#pragma unroll
                for (int n = 0; n < 2; ++n) acc[a][b][m][n] = (f32x4){0.f, 0.f, 0.f, 0.f};
    bf16x8 At[4][2], B0[2][2], B1[2][2];
    const char* cA = (const char*)g.A + (size_t)cur.pm * tstep; const char* cB = (const char*)g.Bt + (size_t)cur.pn * tstep;
    S.a_ready(cur);
    PG8_STAGE(PG8_SB(0, 0), cB, voffB); PG8_STAGE(PG8_SA(0, 0), cA, voffA); PG8_STAGE(PG8_SB(0, 1), cB + hstep, voffB); PG8_STAGE(PG8_SA(0, 1), cA + hstep, voffA);
    if (wr == 1) PG8_BAR;
    PG8_WAIT_V(4); PG8_BAR;
    PG8_STAGE(PG8_SB(1, 0), cB + kstep, voffB); PG8_STAGE(PG8_SA(1, 0), cA + kstep, voffA); PG8_STAGE(PG8_SB(1, 1), cB + hstep + kstep, voffB);
    PG8_WAIT_V(6); PG8_BAR;
    PG8_STAMP();
    for (;;) {
        const bool has_next = S.next(ui + 1, nxt);
        const char* nA = has_next ? (const char*)g.A + (size_t)nxt.pm * tstep : cA; const char* nB = has_next ? (const char*)g.Bt + (size_t)nxt.pn * tstep : cB;
        for (int t = 0; t < nt; t += 2) {
            const bool last = (t == nt - 2);
            const char* a1 = cA + (size_t)(t + 1) * kstep;
            const char* a2 = last ? nA : cA + (size_t)(t + 2) * kstep; const char* b2 = last ? nB : cB + (size_t)(t + 2) * kstep;
            const char* a3 = a2 + kstep; const char* b3 = b2 + kstep;
            if (last && has_next) S.a_ready(nxt);
            PG8_LDB(B0, 0, 0); PG8_SCHED; PG8_LDA(At, 0, 0); PG8_STAGE(PG8_SA(1, 1), a1 + hstep, voffA);
            PG8_WAIT_L(8); PG8_BAR; PG8_WAIT_L(0); PG8_MMA(0, 0, At, B0); PG8_BAR; PG8_SCHED;
            PG8_LDB(B1, 0, 1); PG8_STAGE(PG8_SB(0, 0), b2, voffB);
            PG8_BAR; PG8_WAIT_L(0); PG8_MMA(0, 1, At, B1); PG8_BAR;
            PG8_LDA(At, 0, 1); PG8_STAGE(PG8_SA(0, 0), a2, voffA);
            PG8_BAR; PG8_WAIT_L(0); PG8_MMA(1, 0, At, B0); PG8_BAR; PG8_SCHED;
            PG8_STAGE(PG8_SB(0, 1), b2 + hstep, voffB);
            PG8_WAIT_V(6); PG8_BAR; PG8_MMA(1, 1, At, B1); PG8_BAR;
            PG8_LDB(B0, 1, 0); PG8_SCHED; PG8_LDA(At, 1, 0); PG8_STAGE(PG8_SA(0, 1), a2 + hstep, voffA);
            PG8_WAIT_L(8); PG8_BAR; PG8_WAIT_L(0); PG8_MMA(0, 0, At, B0); PG8_BAR; PG8_SCHED;
            PG8_LDB(B1, 1, 1); PG8_STAGE(PG8_SB(1, 0), b3, voffB);
            PG8_BAR; PG8_WAIT_L(0); PG8_MMA(0, 1, At, B1); PG8_BAR;
            PG8_LDA(At, 1, 1); PG8_STAGE(PG8_SA(1, 0), a3, voffA);
            PG8_BAR; PG8_WAIT_L(0); PG8_MMA(1, 0, At, B0); PG8_BAR; PG8_SCHED;
            PG8_STAGE(PG8_SB(1, 1), b3 + hstep, voffB);
            PG8_WAIT_V(6); PG8_BAR; PG8_MMA(1, 1, At, B1); PG8_BAR;
        }
        PG8_STAMP();
        if constexpr (!Epi::AFTER_DRAIN) { E(acc, cur, wr, wc, fr, fq); S.done(cur); }
        PG8_STAMP();
        if (!has_next) break;
#pragma unroll
        for (int a = 0; a < 2; ++a)
#pragma unroll
            for (int b = 0; b < 2; ++b)
#pragma unroll
                for (int m = 0; m < 4; ++m)
#pragma unroll
                    for (int n = 0; n < 2; ++n) acc[a][b][m][n] = (f32x4){0.f, 0.f, 0.f, 0.f};
        cur = nxt; cA = nA; cB = nB; ++ui;
    }
    PG8_WAIT_V(0);
    if (wr == 0) PG8_BAR;
    PG8_BAR;
    if constexpr (Epi::AFTER_DRAIN) { E.fused(acc, cur, wr, wc, fr, fq, lds, wid, lane); S.done(cur); }
    PG8_STAMP();
    if (STAMP && wid == 0) { stamps[lane] = lane < nts ? (((unsigned long long)(unsigned)ts_hi << 32) | (unsigned)ts_lo) : 0ull;
        if (lane == 62) stamps[62] = rt_entry; if (lane == 63) stamps[63] = (unsigned long long)wall_clock64(); }
#undef PG8_STAMP
#undef PG8_SA
#undef PG8_SB
#undef PG8_STAGE
#undef PG8_LDA
#undef PG8_LDB
#undef PG8_MMA
#undef PG8_WAIT_V
#undef PG8_WAIT_L
#undef PG8_BAR
#undef PG8_SCHED
}
}

using pg8::bf16_t; using pg8::bf16x8; using pg8::f32x4; using pg8::u32x4; using pg8::cvt_pk_bf16;
typedef unsigned u32x2 __attribute__((ext_vector_type(2)));
typedef float f32x2 __attribute__((ext_vector_type(2)));

constexpr int DM = 1024, FF = 2816, TP = 16384, MS = 1024, MT = 17408;
constexpr int NQKV = 1536, NRIN = 6144, NPOS = 16392;
constexpr float LN_EPS = 1e-5f;
constexpr float ALPHA = 1.4142135623730951f;
constexpr int LDS_BYTES = 131072;
constexpr int NPH = 24;

constexpr size_t OUT_Y = 0;
constexpr size_t OUT_KP = (size_t)MT * DM;
constexpr size_t OUT_VP = OUT_KP + 32768;
constexpr size_t OUT_KS = OUT_VP + 32768;
constexpr size_t OUT_VS = OUT_KS + 4194304;
constexpr size_t OUT_SP = OUT_VS + 4194304;
constexpr size_t OUT_SS = OUT_SP + 524288;
constexpr size_t OUT_END = OUT_SS + 67108864;

constexpr size_t al256(size_t x) { return (x + 255) & ~(size_t)255; }
constexpr size_t SZ_WGU = (size_t)2 * FF * DM * 2, SZ_WD = (size_t)DM * FF * 2;
constexpr size_t WS_WGU = 0;
constexpr size_t WS_WD = WS_WGU + 4 * SZ_WGU;
constexpr size_t WS_WQKV = WS_WD + 4 * SZ_WD;
constexpr size_t WS_WO = WS_WQKV + (size_t)NQKV * DM * 2;
constexpr size_t WS_WRIN = WS_WO + (size_t)DM * DM * 2;
constexpr size_t WS_WRO = WS_WRIN + (size_t)NRIN * DM * 2;
constexpr size_t WS_ROPEA = WS_WRO + (size_t)DM * 2048 * 2;
constexpr size_t WS_ROPER = WS_ROPEA + (size_t)NPOS * 32 * 8;
constexpr size_t WS_XF = al256(WS_ROPER + (size_t)NPOS * 128 * 8);
constexpr size_t WS_XB = WS_XF + (size_t)MT * DM * 4;
constexpr size_t WS_Z = WS_XB + (size_t)MT * DM * 2;
constexpr size_t WS_H = WS_Z + (size_t)MT * DM * 4;
constexpr size_t WS_MIX = WS_H + (size_t)MT * FF * 2;
constexpr size_t WS_QR = WS_MIX;
constexpr size_t WS_KR = WS_QR + (size_t)MT * 1024 * 2;
constexpr size_t WS_VB = WS_KR + (size_t)MT * 256 * 2;
constexpr size_t WS_OB = WS_VB + (size_t)MT * 256 * 2;
constexpr size_t WS_RQ = WS_MIX;
constexpr size_t WS_RKZ = WS_RQ + (size_t)MT * 1024 * 2;
constexpr size_t WS_RV = WS_RKZ + (size_t)MT * 1024 * 2;
constexpr size_t WS_RG = WS_RV + (size_t)MT * 2048 * 2;
constexpr size_t WS_U = WS_RG + (size_t)MT * 2048 * 2;
constexpr size_t WS_SB = WS_U + (size_t)128 * 4 * 512 * 256 * 4;
constexpr size_t WS_END = WS_SB + (size_t)128 * 4 * 512 * 256 * 2;
constexpr size_t WS_ATT = WS_XB;
constexpr size_t WS_ORET = WS_Z;
constexpr size_t WS_YB = WS_RQ;
constexpr size_t WS_XCH = WS_END;
constexpr size_t WS_CNT = WS_XCH + 524288;
constexpr size_t WS_TMO = WS_CNT + 6 * 16384;
constexpr size_t WS_PART = WS_TMO + 256;
constexpr size_t WS_END2 = WS_PART + (size_t)4 * MS * DM * 4;

struct Params { const float* in[18]; float* out; unsigned char* ws; int lo, hi; };

__device__ __forceinline__ float bf2f(unsigned short b) { return __uint_as_float(((unsigned)b) << 16); }
__device__ __forceinline__ float bflo(unsigned w) { return __uint_as_float(w << 16); }
__device__ __forceinline__ float bfhi(unsigned w) { return __uint_as_float(w & 0xffff0000u); }
__device__ __forceinline__ float lg2gamma(int h) { return log2f(1.0f - exp2f(-5.0f - (float)h)); }
__device__ __forceinline__ float silu_f(float x) { return x / (1.0f + __expf(-x)); }
__device__ __forceinline__ float wave_sum(float v) {
    v += __shfl_xor(v, 32); v += __shfl_xor(v, 16); v += __shfl_xor(v, 8); v += __shfl_xor(v, 4); v += __shfl_xor(v, 2); v += __shfl_xor(v, 1); return v; }

struct EpiSwiGLU {
    static constexpr bool PERM = false, AFTER_DRAIN = false;
    bf16_t* H;
    __device__ __forceinline__ void operator()(const f32x4 (&acc)[2][2][4][2], const pg8::Unit& u, int wr, int wc, int fr, int fq) const {
        const int row0 = u.pm * 256 + wr * 64 + fr, col0 = u.pn * 128 + wc * 32 + 4 * fq;
#pragma unroll
        for (int ai = 0; ai < 2; ++ai)
#pragma unroll
            for (int m = 0; m < 4; ++m) {
                bf16_t* rowp = H + (size_t)(row0 + ai * 128 + m * 16) * FF + col0;
#pragma unroll
                for (int n = 0; n < 2; ++n) {
                    const f32x4 g = acc[ai][0][m][n], up = acc[ai][1][m][n];
                    u32x2 w; w.x = cvt_pk_bf16(silu_f(g[0]) * up[0], silu_f(g[1]) * up[1]); w.y = cvt_pk_bf16(silu_f(g[2]) * up[2], silu_f(g[3]) * up[3]);
                    *(u32x2*)(rowp + n * 16) = w;
                }
            }
    }
};
struct EpiResid {
    static constexpr bool PERM = false, AFTER_DRAIN = false;
    const float* X; float* Z; float scale;
    __device__ __forceinline__ void operator()(const f32x4 (&acc)[2][2][4][2], const pg8::Unit& u, int wr, int wc, int fr, int fq) const {
        const int row0 = u.pm * 256 + wr * 64 + fr, col0 = u.pn * 256 + wc * 32 + 4 * fq;
#pragma unroll
        for (int ai = 0; ai < 2; ++ai)
#pragma unroll
            for (int m = 0; m < 4; ++m) {
                const size_t off = (size_t)(row0 + ai * 128 + m * 16) * DM + col0;
#pragma unroll
                for (int bj = 0; bj < 2; ++bj)
#pragma unroll
                    for (int n = 0; n < 2; ++n) {
                        const f32x4 x = *(const f32x4*)(X + off + bj * 128 + n * 16);
                        *(f32x4*)(Z + off + bj * 128 + n * 16) = x * ALPHA + acc[ai][bj][m][n] * scale;
                    }
            }
    }
};

struct EpiResidLN {
    static constexpr bool PERM = false, AFTER_DRAIN = true;
    const float* X; float scale; const float* g; const float* b; float* Xf; bf16_t* Xb; pg8::PanelStats st;
    __device__ __forceinline__ void fused(f32x4 (&acc)[2][2][4][2], const pg8::Unit& u, int wr, int wc, int fr, int fq, PG8_LAS unsigned char* lds, int wid, int lane) const {
        const PG8_LAS f32x2* S = (const PG8_LAS f32x2*)(lds + 8192);
        const int col0 = u.pn * 256 + wc * 32 + 4 * fq;
#pragma unroll
        for (int ai = 0; ai < 2; ++ai)
#pragma unroll
            for (int m = 0; m < 4; ++m) { const size_t off = (size_t)(u.pm * 256 + ai * 128 + wr * 64 + m * 16 + fr) * DM + col0;
#pragma unroll
                for (int bj = 0; bj < 2; ++bj)
#pragma unroll
                    for (int n = 0; n < 2; ++n) { const f32x4 x = *(const f32x4*)(X + off + bj * 128 + n * 16); acc[ai][bj][m][n] = x * ALPHA + acc[ai][bj][m][n] * scale; }
                asm volatile("" : "+v"(acc[ai][0][m][0]), "+v"(acc[ai][0][m][1]), "+v"(acc[ai][1][m][0]), "+v"(acc[ai][1][m][1]));
                asm volatile("" ::: "memory"); }
        const bool bad = st.run(acc, u, wr, wc, fr, fq, lds, wid, lane);
        f32x4 gv[2][2], bv[2][2];
#pragma unroll
        for (int bj = 0; bj < 2; ++bj)
#pragma unroll
            for (int n = 0; n < 2; ++n) { gv[bj][n] = *(const f32x4*)(g + col0 + bj * 128 + n * 16); bv[bj][n] = *(const f32x4*)(b + col0 + bj * 128 + n * 16); }
        const float qnan = __builtin_nanf("");
#pragma unroll
        for (int ai = 0; ai < 2; ++ai)
#pragma unroll
            for (int m = 0; m < 4; ++m) { const int r = ai * 128 + wr * 64 + m * 16 + fr; const f32x2 sr = S[r]; const size_t off = (size_t)(u.pm * 256 + r) * DM + col0;
#pragma unroll
                for (int bj = 0; bj < 2; ++bj)
#pragma unroll
                    for (int n = 0; n < 2; ++n) { f32x4 y = (acc[ai][bj][m][n] - sr.x) * sr.y * gv[bj][n] + bv[bj][n];
                        if (bad) y = (f32x4){qnan, qnan, qnan, qnan};
                        *(f32x4*)(Xf + off + bj * 128 + n * 16) = y;
                        u32x2 w; w.x = cvt_pk_bf16(y[0], y[1]); w.y = cvt_pk_bf16(y[2], y[3]); *(u32x2*)(Xb + off + bj * 128 + n * 16) = w; } }
    }
};
struct EpiQKV {
    static constexpr bool PERM = false, AFTER_DRAIN = false;
    bf16_t* Qr; bf16_t* Kr; bf16_t* Vb; const float* ropeA; float* out;
    __device__ __forceinline__ void operator()(const f32x4 (&acc)[2][2][4][2], const pg8::Unit& u, int wr, int wc, int fr, int fq) const {
        const int pn = u.pn;
#pragma unroll
        for (int ai = 0; ai < 2; ++ai)
#pragma unroll
            for (int m = 0; m < 4; ++m) {
                const int row = u.pm * 256 + ai * 128 + wr * 64 + m * 16 + fr;
                const int pos = row < TP ? row : TP + (row & 7);
                long wk = -1;
                bool wsamp = false;
                if (row >= TP) { const int b = (row - TP) >> 3, t = row & 7; wk = ((long)(b * 128 + 120 + t) * 4) * 64; wsamp = true; }
                else if (row >= TP - 128) { wk = ((long)(row - (TP - 128)) * 4) * 64; }
                if (pn < 5) {
#pragma unroll
                    for (int bj = 0; bj < 2; ++bj)
#pragma unroll
                        for (int n = 0; n < 2; ++n) {
                            const int hl = 2 * bj + (wc >> 1);
                            const int i = 2 * (8 * (wc & 1) + 4 * n + fq);
                            const f32x4 cs = *(const f32x4*)(ropeA + ((size_t)pos * 32 + i) * 2);
                            const f32x4 v = acc[ai][bj][m][n];
                            float lo0 = v[0] * cs[0] - v[1] * cs[1], hi0 = v[1] * cs[0] + v[0] * cs[1];
                            float lo1 = v[2] * cs[2] - v[3] * cs[3], hi1 = v[3] * cs[2] + v[2] * cs[3];
                            if (pn < 4) {
                                bf16_t* p = Qr + (size_t)row * 1024 + (pn * 4 + hl) * 64 + i;
                                *(unsigned*)p = cvt_pk_bf16(lo0 * 0.125f, lo1 * 0.125f);
                                *(unsigned*)(p + 32) = cvt_pk_bf16(hi0 * 0.125f, hi1 * 0.125f);
                            } else {
                                bf16_t* p = Kr + (size_t)row * 256 + hl * 64 + i;
                                *(unsigned*)p = cvt_pk_bf16(lo0, lo1);
                                *(unsigned*)(p + 32) = cvt_pk_bf16(hi0, hi1);
                                if (wk >= 0) {
                                    float* o = out + (wsamp ? OUT_KS : OUT_KP) + wk + hl * 64 + i;
                                    *(f32x2*)o = (f32x2){lo0, lo1}; *(f32x2*)(o + 32) = (f32x2){hi0, hi1};
                                }
                            }
                        }
                } else {
#pragma unroll
                    for (int bj = 0; bj < 2; ++bj)
#pragma unroll
                        for (int n = 0; n < 2; ++n) {
                            const int cc = bj * 128 + wc * 32 + n * 16 + 4 * fq;
                            const f32x4 v = acc[ai][bj][m][n];
                            u32x2 w; w.x = cvt_pk_bf16(v[0], v[1]); w.y = cvt_pk_bf16(v[2], v[3]);
                            *(u32x2*)(Vb + (size_t)row * 256 + cc) = w;
                            if (wk >= 0) *(f32x4*)(out + (wsamp ? OUT_VS : OUT_VP) + wk + cc) = v;
                        }
                }
            }
    }
};
struct EpiRet {
    static constexpr bool PERM = false, AFTER_DRAIN = false;
    bf16_t* RQ; bf16_t* RKZ; bf16_t* RV; bf16_t* RG; const float* ropeR;
    __device__ __forceinline__ void operator()(const f32x4 (&acc)[2][2][4][2], const pg8::Unit& u, int wr, int wc, int fr, int fq) const {
        const int pn = u.pn;
        const float lg = lg2gamma(pn & 3);
#pragma unroll
        for (int ai = 0; ai < 2; ++ai)
#pragma unroll
            for (int m = 0; m < 4; ++m) {
                const int row = u.pm * 256 + ai * 128 + wr * 64 + m * 16 + fr;
                const int pos = row < TP ? row : TP + (row & 7);
                if (pn < 8) {
                    float sc = 1.0f;
                    if (pn >= 4) { const int jj = row < TP ? 127 - (row & 127) : 7 - (row & 7); sc = 0.0625f * exp2f((float)jj * lg); }
                    bf16_t* dst = (pn < 4 ? RQ : RKZ) + (size_t)row * 1024 + (pn & 3) * 256;
#pragma unroll
                    for (int bj = 0; bj < 2; ++bj)
#pragma unroll
                        for (int n = 0; n < 2; ++n) {
                            const int dk = bj * 128 + wc * 32 + n * 16 + 4 * fq;
                            const f32x4 cs = *(const f32x4*)(ropeR + ((size_t)pos * 128 + (dk >> 1)) * 2);
                            const f32x4 v = acc[ai][bj][m][n];
                            const float o0 = (v[0] * cs[0] - v[1] * cs[1]) * sc, o1 = (v[1] * cs[0] + v[0] * cs[1]) * sc;
                            const float o2 = (v[2] * cs[2] - v[3] * cs[3]) * sc, o3 = (v[3] * cs[2] + v[2] * cs[3]) * sc;
                            u32x2 w; w.x = cvt_pk_bf16(o0, o1); w.y = cvt_pk_bf16(o2, o3);
                            *(u32x2*)(dst + dk) = w;
                        }
                } else {
                    const bool isg = pn >= 16;
                    bf16_t* dst = (isg ? RG : RV) + (size_t)row * 2048 + ((pn - 8) & 7) * 256;
#pragma unroll
                    for (int bj = 0; bj < 2; ++bj)
#pragma unroll
                        for (int n = 0; n < 2; ++n) {
                            const int cc = bj * 128 + wc * 32 + n * 16 + 4 * fq;
                            f32x4 v = acc[ai][bj][m][n];
                            if (isg) { v[0] = silu_f(v[0]); v[1] = silu_f(v[1]); v[2] = silu_f(v[2]); v[3] = silu_f(v[3]); }
                            u32x2 w; w.x = cvt_pk_bf16(v[0], v[1]); w.y = cvt_pk_bf16(v[2], v[3]);
                            *(u32x2*)(dst + cc) = w;
                        }
                }
            }
    }
};

__device__ void conv_job(const float* src0, const float* src1, bf16_t* dst, int K, int Nsrc, int Ndst, int mode, float* tile) {
    const int ntn = Ndst / 64, ntk = K / 64, tid = otid();
    for (int t = obid(); t < ntn * ntk; t += gridDim.x) {
        const int tn = t % ntn, tk = t / ntn, n0 = tn * 64, k0 = tk * 64;
        const int tx = tid & 63, ty = tid >> 6;
        const int v = n0 + tx; const float* s = src0; int col = v;
        if (mode == 1) { const int pn = v >> 8, bj = (v >> 7) & 1, rest = v & 127; col = pn * 128 + rest; s = bj ? src1 : src0; }
        else if (mode == 2) { if (v < 1280) { const int head = v >> 6, p = v & 63, a = p >> 2, b = p & 3; col = head * 64 + 2 * a + (b >> 1) + 32 * (b & 1); } }
        __syncthreads();
#pragma unroll
        for (int i = 0; i < 8; ++i) { const int kk = ty * 8 + i; tile[kk * 65 + tx] = s[(size_t)(k0 + kk) * Nsrc + col]; }
        __syncthreads();
        const int ny = tid >> 3, kc = (tid & 7) * 8;
        u32x4 w;
        w.x = cvt_pk_bf16(tile[(kc + 0) * 65 + ny], tile[(kc + 1) * 65 + ny]); w.y = cvt_pk_bf16(tile[(kc + 2) * 65 + ny], tile[(kc + 3) * 65 + ny]);
        w.z = cvt_pk_bf16(tile[(kc + 4) * 65 + ny], tile[(kc + 5) * 65 + ny]); w.w = cvt_pk_bf16(tile[(kc + 6) * 65 + ny], tile[(kc + 7) * 65 + ny]);
        *(u32x4*)(dst + (size_t)(n0 + ny) * K + k0 + kc) = w;
    }
}
__device__ void phase0(const Params& P, unsigned char* lds) {
    float* tile = (float*)lds; unsigned char* ws = P.ws;
    for (int l = 0; l < 2; ++l)
        for (int f = 0; f < 2; ++f) {
            const float* wg = P.in[f ? 8 : 5] + (size_t)l * DM * FF; const float* wu = P.in[f ? 9 : 6] + (size_t)l * DM * FF; const float* wd = P.in[f ? 10 : 7] + (size_t)l * FF * DM;
            conv_job(wg, wu, (bf16_t*)(ws + WS_WGU + (size_t)(l * 2 + f) * SZ_WGU), DM, FF, 2 * FF, 1, tile);
            conv_job(wd, wd, (bf16_t*)(ws + WS_WD + (size_t)(l * 2 + f) * SZ_WD), FF, DM, DM, 0, tile);
        }
    conv_job(P.in[13], P.in[13], (bf16_t*)(ws + WS_WQKV), DM, NQKV, NQKV, 2, tile);
    conv_job(P.in[14], P.in[14], (bf16_t*)(ws + WS_WO), DM, DM, DM, 0, tile);
    conv_job(P.in[16], P.in[16], (bf16_t*)(ws + WS_WRIN), DM, NRIN, NRIN, 0, tile);
    conv_job(P.in[17], P.in[17], (bf16_t*)(ws + WS_WRO), 2048, DM, DM, 0, tile);
    const size_t gt = (size_t)obid() * blockDim.x + otid(), gs = (size_t)gridDim.x * blockDim.x;
    float* ra = (float*)(ws + WS_ROPEA); float* rr = (float*)(ws + WS_ROPER);
    for (size_t i = gt; i < (size_t)NPOS * 32; i += gs) { const int pos = (int)(i >> 5), k = (int)(i & 31);
        const float inv = powf(10000.0f, -(float)(2 * k) / 64.0f); const float ang = (float)pos * inv; float s, c; sincosf(ang, &s, &c); *(f32x2*)(ra + i * 2) = (f32x2){c, s}; }
    for (size_t i = gt; i < (size_t)NPOS * 128; i += gs) { const int pos = (int)(i >> 7), k = (int)(i & 127);
        const float inv = 1.0f / powf(10000.0f, (float)k / 127.0f); const float ang = (float)pos * inv; float s, c; sincosf(ang, &s, &c); *(f32x2*)(rr + i * 2) = (f32x2){c, s}; }
    float* XF = (float*)(ws + WS_XF); bf16_t* XB = (bf16_t*)(ws + WS_XB);
    for (size_t i = gt; i < (size_t)MT * DM / 4; i += gs) {
        const size_t e = i * 4; const f32x4 v = e < (size_t)TP * DM ? *(const f32x4*)(P.in[0] + e) : *(const f32x4*)(P.in[1] + (e - (size_t)TP * DM));
        *(f32x4*)(XF + e) = v; u32x2 w; w.x = cvt_pk_bf16(v[0], v[1]); w.y = cvt_pk_bf16(v[2], v[3]); *(u32x2*)(XB + e) = w; }
}

__device__ void ln_phase(const float* Z, const float* g, const float* b, float* Xf, bf16_t* Xb) {
    const int wave = otid() >> 6, lane = otid() & 63;
    f32x4 gv[4], bv[4];
#pragma unroll
    for (int i = 0; i < 4; ++i) { gv[i] = *(const f32x4*)(g + 256 * i + 4 * lane); bv[i] = *(const f32x4*)(b + 256 * i + 4 * lane); }
    for (int r = obid() * 8 + wave; r < MT; r += gridDim.x * 8) {
        f32x4 v[4]; float s = 0.f;
#pragma unroll
        for (int i = 0; i < 4; ++i) { v[i] = *(const f32x4*)(Z + (size_t)r * DM + 256 * i + 4 * lane); s += (v[i][0] + v[i][1]) + (v[i][2] + v[i][3]); }
        const float mu = wave_sum(s) * (1.0f / 1024.0f); float q = 0.f;
#pragma unroll
        for (int i = 0; i < 4; ++i) { v[i] -= mu; q += (v[i][0] * v[i][0] + v[i][1] * v[i][1]) + (v[i][2] * v[i][2] + v[i][3] * v[i][3]); }
        const float rstd = rsqrtf(wave_sum(q) * (1.0f / 1024.0f) + LN_EPS);
#pragma unroll
        for (int i = 0; i < 4; ++i) { const f32x4 y = v[i] * rstd * gv[i] + bv[i];
            *(f32x4*)(Xf + (size_t)r * DM + 256 * i + 4 * lane) = y;
            u32x2 w; w.x = cvt_pk_bf16(y[0], y[1]); w.y = cvt_pk_bf16(y[2], y[3]); *(u32x2*)(Xb + (size_t)r * DM + 256 * i + 4 * lane) = w; }
    }
}


__device__ void sample_ln_phase(const float* XFs, const float* part, float scale, const float* g, const float* b, float* Xf, bf16_t* Xb) {
    const int wave = otid() >> 6, lane = otid() & 63;
    for (int r = obid() * 8 + wave; r < MS; r += gridDim.x * 8) {
        f32x4 v[4]; float s = 0.f;
#pragma unroll
        for (int i = 0; i < 4; ++i) { const size_t o = (size_t)r * DM + 256 * i + 4 * lane;
            f32x4 p = *(const f32x4*)(part + o); p += *(const f32x4*)(part + o + (size_t)MS * DM); p += *(const f32x4*)(part + o + (size_t)2 * MS * DM); p += *(const f32x4*)(part + o + (size_t)3 * MS * DM);
            v[i] = *(const f32x4*)(XFs + o) * ALPHA + p * scale; s += (v[i][0] + v[i][1]) + (v[i][2] + v[i][3]); }
        const float mu = wave_sum(s) * (1.0f / 1024.0f); float q = 0.f;
#pragma unroll
        for (int i = 0; i < 4; ++i) { v[i] -= mu; q += (v[i][0] * v[i][0] + v[i][1] * v[i][1]) + (v[i][2] * v[i][2] + v[i][3] * v[i][3]); }
        const float rstd = rsqrtf(wave_sum(q) * (1.0f / 1024.0f) + LN_EPS);
#pragma unroll
        for (int i = 0; i < 4; ++i) { const size_t o = (size_t)r * DM + 256 * i + 4 * lane;
            const f32x4 y = v[i] * rstd * *(const f32x4*)(g + 256 * i + 4 * lane) + *(const f32x4*)(b + 256 * i + 4 * lane);
            *(f32x4*)(Xf + o) = y; u32x2 w; w.x = cvt_pk_bf16(y[0], y[1]); w.y = cvt_pk_bf16(y[2], y[3]); *(u32x2*)(Xb + o) = w; }
    }
}

__device__ void ln_all_phase(const float* Z, const float* XFs, const float* part, float scale, const float* g, const float* b, float* XfP, float* XfS, bf16_t* Xb) {
    const int wave = otid() >> 6, lane = otid() & 63;
    f32x4 gv[4], bv[4];
#pragma unroll
    for (int i = 0; i < 4; ++i) { gv[i] = *(const f32x4*)(g + 256 * i + 4 * lane); bv[i] = *(const f32x4*)(b + 256 * i + 4 * lane); }
    for (int r = obid() * 8 + wave; r < MT; r += gridDim.x * 8) {
        f32x4 v[4]; float s = 0.f;
        if (r < TP) {
#pragma unroll
            for (int i = 0; i < 4; ++i) v[i] = *(const f32x4*)(Z + (size_t)r * DM + 256 * i + 4 * lane);
        } else {
#pragma unroll
            for (int i = 0; i < 4; ++i) { const size_t o = (size_t)(r - TP) * DM + 256 * i + 4 * lane;
                f32x4 p = *(const f32x4*)(part + o); p += *(const f32x4*)(part + o + (size_t)MS * DM); p += *(const f32x4*)(part + o + (size_t)2 * MS * DM); p += *(const f32x4*)(part + o + (size_t)3 * MS * DM);
                v[i] = *(const f32x4*)(XFs + o) * ALPHA + p * scale; }
        }
#pragma unroll
        for (int i = 0; i < 4; ++i) s += (v[i][0] + v[i][1]) + (v[i][2] + v[i][3]);
        const float mu = wave_sum(s) * (1.0f / 1024.0f); float q = 0.f;
#pragma unroll
        for (int i = 0; i < 4; ++i) { v[i] -= mu; q += (v[i][0] * v[i][0] + v[i][1] * v[i][1]) + (v[i][2] * v[i][2] + v[i][3] * v[i][3]); }
        const float rstd = rsqrtf(wave_sum(q) * (1.0f / 1024.0f) + LN_EPS);
        float* dst = r < TP ? XfP + (size_t)r * DM : XfS + (size_t)(r - TP) * DM;
#pragma unroll
        for (int i = 0; i < 4; ++i) { const f32x4 y = v[i] * rstd * gv[i] + bv[i];
            *(f32x4*)(dst + 256 * i + 4 * lane) = y;
            u32x2 w; w.x = cvt_pk_bf16(y[0], y[1]); w.y = cvt_pk_bf16(y[2], y[3]); *(u32x2*)(Xb + (size_t)r * DM + 256 * i + 4 * lane) = w; }
    }
}
__device__ __forceinline__ u32x4 ld8_f32_as_bf16(const float* p) { const f32x4 a = *(const f32x4*)p, b = *(const f32x4*)(p + 4);
    u32x4 w; w.x = cvt_pk_bf16(a[0], a[1]); w.y = cvt_pk_bf16(a[2], a[3]); w.z = cvt_pk_bf16(b[0], b[1]); w.w = cvt_pk_bf16(b[2], b[3]); return w; }
__device__ void attn_phase(const Params& P, unsigned char* lds) {
    unsigned char* ws = P.ws;
    const bf16_t* Qr = (const bf16_t*)(ws + WS_QR); const bf16_t* Kr = (const bf16_t*)(ws + WS_KR); const bf16_t* Vb = (const bf16_t*)(ws + WS_VB); bf16_t* Ob = (bf16_t*)(ws + WS_OB);
    const float* cache_k = P.in[2]; const float* cache_v = P.in[3]; const float* sinks = P.in[15];
    bf16_t* Ks = (bf16_t*)lds;
    bf16_t* Vt = (bf16_t*)(lds + 23040);
    const int tid = otid(), wave = tid >> 6, lane = tid & 63, fr = lane & 15, fq = lane >> 4;
    for (int it = obid(); it < 2048 + 512; it += gridDim.x) {
        const bool samp = it >= 2048;
        int kh, q0 = 0, b = 0;
        if (!samp) { kh = it & 3; q0 = (it >> 2) * 32; } else { const int s = it - 2048; kh = s & 3; b = s >> 2; }
        __syncthreads();
        for (int c = tid; c < 1280; c += 512) {
            const int row = c >> 3, ch = c & 7; u32x4 w = (u32x4){0u, 0u, 0u, 0u};
            if (!samp) { const int kp = q0 - 128 + row; if (kp >= 0) w = *(const u32x4*)(Kr + (size_t)kp * 256 + kh * 64 + ch * 8); }
            else { if (row < 128) w = ld8_f32_as_bf16(cache_k + ((size_t)(b * 128 + row) * 4 + kh) * 64 + ch * 8);
                   else if (row < 136) w = *(const u32x4*)(Kr + (size_t)(TP + b * 8 + row - 128) * 256 + kh * 64 + ch * 8); }
            *(u32x4*)(Ks + row * 72 + ch * 8) = w;
        }
#pragma unroll
        for (int i = 0; i < 3; ++i) {
            const int key = lane + 64 * i, dc = wave;
            if (key < 160) {
                u32x4 w = (u32x4){0u, 0u, 0u, 0u};
                if (!samp) { const int kp = q0 - 128 + key; if (kp >= 0) w = *(const u32x4*)(Vb + (size_t)kp * 256 + kh * 64 + dc * 8); }
                else { if (key < 128) w = ld8_f32_as_bf16(cache_v + ((size_t)(b * 128 + key) * 4 + kh) * 64 + dc * 8);
                       else if (key < 136) w = *(const u32x4*)(Vb + (size_t)(TP + b * 8 + key - 128) * 256 + kh * 64 + dc * 8); }
                bf16_t* vp = Vt + (dc * 8) * 200 + key;
                vp[0 * 200] = (bf16_t)(w.x & 0xffff); vp[1 * 200] = (bf16_t)(w.x >> 16); vp[2 * 200] = (bf16_t)(w.y & 0xffff); vp[3 * 200] = (bf16_t)(w.y >> 16);
                vp[4 * 200] = (bf16_t)(w.z & 0xffff); vp[5 * 200] = (bf16_t)(w.z >> 16); vp[6 * 200] = (bf16_t)(w.w & 0xffff); vp[7 * 200] = (bf16_t)(w.w >> 16);
            }
        }
        __syncthreads();
        if (wave < (samp ? 2 : 8)) {
            int g, rowg, qrel;
            if (!samp) { g = wave >> 1; qrel = q0 + 16 * (wave & 1) + fr; rowg = qrel; }
            else { const int r = 16 * wave + fr; g = r >> 3; qrel = r & 7; rowg = TP + b * 8 + qrel; }
            const int head = kh * 4 + g;
            const bf16_t* qp = Qr + (size_t)rowg * 1024 + head * 64 + fq * 8;
            const bf16x8 qf0 = *(const bf16x8*)qp, qf1 = *(const bf16x8*)(qp + 32);
            f32x4 s[10];
#pragma unroll
            for (int f = 0; f < 10; ++f) {
                const bf16x8 k0 = *(const bf16x8*)(Ks + (16 * f + fr) * 72 + fq * 8), k1 = *(const bf16x8*)(Ks + (16 * f + fr) * 72 + 32 + fq * 8);
                f32x4 a = (f32x4){0.f, 0.f, 0.f, 0.f};
                a = __builtin_amdgcn_mfma_f32_16x16x32_bf16(k0, qf0, a, 0, 0, 0);
                a = __builtin_amdgcn_mfma_f32_16x16x32_bf16(k1, qf1, a, 0, 0, 0);
                s[f] = a;
            }
            const float sink = sinks[head];
            float mx = sink;
#pragma unroll
            for (int f = 0; f < 10; ++f)
#pragma unroll
                for (int j = 0; j < 4; ++j) {
                    const int idx = 16 * f + 4 * fq + j; bool valid;
                    if (!samp) { const int kp = q0 - 128 + idx; valid = (kp >= 0) && (kp <= qrel) && (qrel - kp < 128); }
                    else { valid = idx < 128 ? (idx > qrel) : (idx - 128 <= qrel); }
                    const float v = valid ? s[f][j] : -INFINITY; s[f][j] = v; mx = fmaxf(mx, v);
                }
            mx = fmaxf(mx, __shfl_xor(mx, 16)); mx = fmaxf(mx, __shfl_xor(mx, 32));
            float sum = 0.f;
#pragma unroll
            for (int f = 0; f < 10; ++f)
#pragma unroll
                for (int j = 0; j < 4; ++j) { const float e = __expf(s[f][j] - mx); s[f][j] = e; sum += e; }
            sum += __shfl_xor(sum, 16); sum += __shfl_xor(sum, 32);
            const float inv = 1.0f / (sum + __expf(sink - mx));
            f32x4 o[4];
#pragma unroll
            for (int d = 0; d < 4; ++d) o[d] = (f32x4){0.f, 0.f, 0.f, 0.f};
#pragma unroll
            for (int st = 0; st < 5; ++st) {
                u32x4 pw; pw.x = cvt_pk_bf16(s[2 * st][0], s[2 * st][1]); pw.y = cvt_pk_bf16(s[2 * st][2], s[2 * st][3]);
                pw.z = cvt_pk_bf16(s[2 * st + 1][0], s[2 * st + 1][1]); pw.w = cvt_pk_bf16(s[2 * st + 1][2], s[2 * st + 1][3]);
                bf16x8 pf; __builtin_memcpy(&pf, &pw, 16);
#pragma unroll
                for (int d = 0; d < 4; ++d) {
                    const bf16_t* vp = Vt + (16 * d + fr) * 200 + 32 * st + 4 * fq;
                    const u32x2 v0 = *(const u32x2*)vp, v1 = *(const u32x2*)(vp + 16);
                    u32x4 vw; vw.x = v0.x; vw.y = v0.y; vw.z = v1.x; vw.w = v1.y;
                    bf16x8 vf; __builtin_memcpy(&vf, &vw, 16);
                    o[d] = __builtin_amdgcn_mfma_f32_16x16x32_bf16(vf, pf, o[d], 0, 0, 0);
                }
            }
#pragma unroll
            for (int d = 0; d < 4; ++d) { u32x2 w; w.x = cvt_pk_bf16(o[d][0] * inv, o[d][1] * inv); w.y = cvt_pk_bf16(o[d][2] * inv, o[d][3] * inv);
                *(u32x2*)(Ob + (size_t)rowg * 1024 + head * 64 + 16 * d + 4 * fq) = w; }
        }
    }
    const size_t gt = (size_t)obid() * blockDim.x + otid(), gs = (size_t)gridDim.x * blockDim.x;
    for (size_t i = gt; i < (size_t)2 * 983040; i += gs) {
        const int which = i >= 983040; const size_t j = which ? i - 983040 : i; const size_t bb = j / 7680, rem = j % 7680;
        const float* src = (which ? cache_v : cache_k) + (bb * 8192 + 512 + rem) * 4;
        *(f32x4*)(P.out + (which ? OUT_VS : OUT_KS) + (bb * 8192 + rem) * 4) = *(const f32x4*)src;
    }
}

template <bool TA, bool TB>
__device__ __forceinline__ void tile_mm(f32x4 (&acc)[4][2], const bf16_t* A, int lda, const bf16_t* B, int ldb, int K, unsigned char* lds) {
    bf16_t* As = (bf16_t*)lds; bf16_t* Bs = As + 128 * 72;
    const int tid = otid(), wave = tid >> 6, lane = tid & 63, wr = wave >> 2, wc = wave & 3, fr = lane & 15, fq = lane >> 4;
    u32x4 ra[2], rb[2];
#define TM_LOAD(k0) do { _Pragma("unroll") for (int i_ = 0; i_ < 2; ++i_) { const int c_ = tid + 512 * i_; \
        if (!TA) ra[i_] = *(const u32x4*)(A + (size_t)(c_ >> 3) * lda + (k0) + (c_ & 7) * 8); else ra[i_] = *(const u32x4*)(A + (size_t)((k0) + (c_ & 63)) * lda + (c_ >> 6) * 8); \
        if (!TB) rb[i_] = *(const u32x4*)(B + (size_t)(c_ >> 3) * ldb + (k0) + (c_ & 7) * 8); else rb[i_] = *(const u32x4*)(B + (size_t)((k0) + (c_ & 63)) * ldb + (c_ >> 6) * 8); } } while (0)
#define TM_ST1(S, r, T) do { _Pragma("unroll") for (int i_ = 0; i_ < 2; ++i_) { const int c_ = tid + 512 * i_; \
        if (!T) *(u32x4*)(S + (c_ >> 3) * 72 + (c_ & 7) * 8) = r[i_]; \
        else { bf16_t* p_ = S + ((c_ >> 6) * 8) * 72 + (c_ & 63); const u32x4 w_ = r[i_]; \
            p_[0] = (bf16_t)(w_.x & 0xffff); p_[72] = (bf16_t)(w_.x >> 16); p_[144] = (bf16_t)(w_.y & 0xffff); p_[216] = (bf16_t)(w_.y >> 16); \
            p_[288] = (bf16_t)(w_.z & 0xffff); p_[360] = (bf16_t)(w_.z >> 16); p_[432] = (bf16_t)(w_.w & 0xffff); p_[504] = (bf16_t)(w_.w >> 16); } } } while (0)
    TM_LOAD(0);
    for (int k0 = 0; k0 < K; k0 += 64) {
        __syncthreads();
        TM_ST1(As, ra, TA); TM_ST1(Bs, rb, TB);
        __syncthreads();
        if (k0 + 64 < K) TM_LOAD(k0 + 64);
#pragma unroll
        for (int ks = 0; ks < 2; ++ks) {
            bf16x8 af[4], bfr[2];
#pragma unroll
            for (int m = 0; m < 4; ++m) af[m] = *(const bf16x8*)(As + (64 * wr + 16 * m + fr) * 72 + ks * 32 + fq * 8);
#pragma unroll
            for (int n = 0; n < 2; ++n) bfr[n] = *(const bf16x8*)(Bs + (32 * wc + 16 * n + fr) * 72 + ks * 32 + fq * 8);
#pragma unroll
            for (int m = 0; m < 4; ++m)
#pragma unroll
                for (int n = 0; n < 2; ++n) acc[m][n] = __builtin_amdgcn_mfma_f32_16x16x32_bf16(bfr[n], af[m], acc[m][n], 0, 0, 0);
        }
    }
#undef TM_LOAD
#undef TM_ST1
}
#define ZERO_ACC(acc) do { _Pragma("unroll") for (int m_ = 0; m_ < 4; ++m_) _Pragma("unroll") for (int n_ = 0; n_ < 2; ++n_) acc[m_][n_] = (f32x4){0.f, 0.f, 0.f, 0.f}; } while (0)

__device__ void ret_phase_a(const Params& P, unsigned char* lds) {
    unsigned char* ws = P.ws;
    const bf16_t* RQ = (const bf16_t*)(ws + WS_RQ); const bf16_t* RKZ = (const bf16_t*)(ws + WS_RKZ); const bf16_t* RV = (const bf16_t*)(ws + WS_RV);
    bf16_t* ATT = (bf16_t*)(ws + WS_ATT); float* U = (float*)(ws + WS_U); float* ORET = (float*)(ws + WS_ORET);
    const int tid = otid(), wave = tid >> 6, lane = tid & 63, wr = wave >> 2, wc = wave & 3, fr = lane & 15, fq = lane >> 4;
    for (int it = obid(); it < 512; it += gridDim.x) {
        const int c = it >> 2, h = it & 3; const float lg = lg2gamma(h);
        f32x4 acc[4][2]; ZERO_ACC(acc);
        tile_mm<false, false>(acc, RQ + (size_t)c * 128 * 1024 + h * 256, 1024, RKZ + (size_t)c * 128 * 1024 + h * 256, 1024, 256, lds);
#pragma unroll
        for (int m = 0; m < 4; ++m) { const int i = 64 * wr + 16 * m + fr; const float sc = exp2f((float)(i - 127) * lg);
#pragma unroll
            for (int n = 0; n < 2; ++n) { const int j = 32 * wc + 16 * n + 4 * fq; const f32x4 v = acc[m][n];
                u32x2 w; w.x = cvt_pk_bf16(j <= i ? v[0] * sc : 0.f, j + 1 <= i ? v[1] * sc : 0.f); w.y = cvt_pk_bf16(j + 2 <= i ? v[2] * sc : 0.f, j + 3 <= i ? v[3] * sc : 0.f);
                *(u32x2*)(ATT + (size_t)it * 16384 + i * 128 + j) = w; } }
    }
    for (int it = obid(); it < 4096; it += gridDim.x) {
        const int dkt = it & 1, dvt = (it >> 1) & 3, ch = it >> 3, c = ch >> 2, h = ch & 3;
        f32x4 acc[4][2]; ZERO_ACC(acc);
        tile_mm<true, true>(acc, RV + (size_t)c * 128 * 2048 + h * 512 + dvt * 128, 2048, RKZ + (size_t)c * 128 * 1024 + h * 256 + dkt * 128, 1024, 128, lds);
        float* base = U + ((size_t)ch * 512 + dvt * 128) * 256 + dkt * 128;
#pragma unroll
        for (int m = 0; m < 4; ++m)
#pragma unroll
            for (int n = 0; n < 2; ++n) *(f32x4*)(base + (size_t)(64 * wr + 16 * m + fr) * 256 + 32 * wc + 16 * n + 4 * fq) = acc[m][n];
    }
    float* qs = (float*)lds;
    float* kzs = (float*)(lds + 8192);
    float* Amat = (float*)(lds + 16384);
    float* part = (float*)(lds + 32768);
    const float* S0 = P.in[4]; float* SN = P.out + OUT_SS;
    for (int it = obid(); it < 512; it += gridDim.x) {
        const int b = it >> 2, h = it & 3; const float lg = lg2gamma(h);
        __syncthreads();
        { const int t = tid >> 6, d4 = (tid & 63) * 4; const size_t off = (size_t)(TP + b * 8 + t) * 1024 + h * 256 + d4;
          const u32x2 qw = *(const u32x2*)(RQ + off), kw = *(const u32x2*)(RKZ + off);
          qs[(d4 + 0) * 8 + t] = bflo(qw.x); qs[(d4 + 1) * 8 + t] = bfhi(qw.x); qs[(d4 + 2) * 8 + t] = bflo(qw.y); qs[(d4 + 3) * 8 + t] = bfhi(qw.y);
          kzs[(d4 + 0) * 8 + t] = bflo(kw.x); kzs[(d4 + 1) * 8 + t] = bfhi(kw.x); kzs[(d4 + 2) * 8 + t] = bflo(kw.y); kzs[(d4 + 3) * 8 + t] = bfhi(kw.y); }
        __syncthreads();
        { const int p = tid >> 3, pt = tid & 7, i = p >> 3, j = p & 7; float s = 0.f;
          for (int d = pt * 32; d < pt * 32 + 32; ++d) s += qs[d * 8 + i] * kzs[d * 8 + j];
          s += __shfl_xor(s, 1); s += __shfl_xor(s, 2); s += __shfl_xor(s, 4);
          if (pt == 0) Amat[p] = (j <= i) ? s * exp2f((float)(i - 7) * lg) : 0.f; }
        const int e4 = tid & 127, dg = tid >> 7;
        f32x4 vv[8];
#pragma unroll
        for (int j = 0; j < 8; ++j) { const u32x2 w = *(const u32x2*)(RV + (size_t)(TP + b * 8 + j) * 2048 + h * 512 + e4 * 4); vv[j] = (f32x4){bflo(w.x), bfhi(w.x), bflo(w.y), bfhi(w.y)}; }
        f32x4 oacc[8];
#pragma unroll
        for (int i = 0; i < 8; ++i) oacc[i] = (f32x4){0.f, 0.f, 0.f, 0.f};
        const float g8 = exp2f(8.0f * lg);
        const size_t sbase = (size_t)it * 131072 + e4 * 4;
#pragma unroll 4
        for (int d = dg * 64; d < dg * 64 + 64; ++d) {
            const f32x4 Sv = *(const f32x4*)(S0 + sbase + (size_t)d * 512);
            const f32x4 q0 = *(const f32x4*)(qs + d * 8), q1 = *(const f32x4*)(qs + d * 8 + 4), k0 = *(const f32x4*)(kzs + d * 8), k1 = *(const f32x4*)(kzs + d * 8 + 4);
            oacc[0] += Sv * q0[0]; oacc[1] += Sv * q0[1]; oacc[2] += Sv * q0[2]; oacc[3] += Sv * q0[3];
            oacc[4] += Sv * q1[0]; oacc[5] += Sv * q1[1]; oacc[6] += Sv * q1[2]; oacc[7] += Sv * q1[3];
            f32x4 sn = Sv * g8;
            sn += vv[0] * k0[0]; sn += vv[1] * k0[1]; sn += vv[2] * k0[2]; sn += vv[3] * k0[3];
            sn += vv[4] * k1[0]; sn += vv[5] * k1[1]; sn += vv[6] * k1[2]; sn += vv[7] * k1[3];
            *(f32x4*)(SN + sbase + (size_t)d * 512) = sn;
        }
#pragma unroll
        for (int i = 0; i < 8; ++i) *(f32x4*)(part + (dg * 8 + i) * 512 + e4 * 4) = oacc[i];
        __syncthreads();
#pragma unroll
        for (int ii = 0; ii < 2; ++ii) { const int i = dg * 2 + ii;
            f32x4 tot = *(const f32x4*)(part + (0 * 8 + i) * 512 + e4 * 4); tot += *(const f32x4*)(part + (1 * 8 + i) * 512 + e4 * 4);
            tot += *(const f32x4*)(part + (2 * 8 + i) * 512 + e4 * 4); tot += *(const f32x4*)(part + (3 * 8 + i) * 512 + e4 * 4);
            f32x4 o = tot * exp2f((float)(i + 1) * lg);
#pragma unroll
            for (int j = 0; j < 8; ++j) o += vv[j] * Amat[i * 8 + j];
            *(f32x4*)(ORET + (size_t)(TP + b * 8 + i) * 2048 + h * 512 + e4 * 4) = o; }
    }
}
__device__ void ret_phase_b(const Params& P) {
    const float* U = (const float*)(P.ws + WS_U); bf16_t* SB = (bf16_t*)(P.ws + WS_SB);
    for (size_t e4 = (size_t)obid() * blockDim.x + otid(); e4 < 131072; e4 += (size_t)gridDim.x * blockDim.x) {
        const size_t idx = e4 * 4; const int h = (int)(idx >> 17); const float a = exp2f(128.0f * lg2gamma(h));
        f32x4 s = (f32x4){0.f, 0.f, 0.f, 0.f};
#pragma unroll 8
        for (int c = 0; c < 128; ++c) {
            u32x2 w; w.x = cvt_pk_bf16(s[0], s[1]); w.y = cvt_pk_bf16(s[2], s[3]);
            *(u32x2*)(SB + (size_t)c * 524288 + idx) = w;
            const f32x4 u = *(const f32x4*)(U + (size_t)c * 524288 + idx);
            s = s * a + u;
        }
        const int rem = (int)(idx & 131071), dv = rem >> 8, dk = rem & 255;
        float* o = P.out + OUT_SP + (size_t)h * 131072 + (size_t)dk * 512 + dv;
        o[0] = s[0]; o[512] = s[1]; o[1024] = s[2]; o[1536] = s[3];
    }
}
__device__ void ret_phase_c(const Params& P, unsigned char* lds) {
    unsigned char* ws = P.ws;
    const bf16_t* RQ = (const bf16_t*)(ws + WS_RQ); const bf16_t* RV = (const bf16_t*)(ws + WS_RV); const bf16_t* ATT = (const bf16_t*)(ws + WS_ATT); const bf16_t* SB = (const bf16_t*)(ws + WS_SB);
    float* ORET = (float*)(ws + WS_ORET);
    const int tid = otid(), wave = tid >> 6, lane = tid & 63, wr = wave >> 2, wc = wave & 3, fr = lane & 15, fq = lane >> 4;
    for (int it = obid(); it < 2048; it += gridDim.x) {
        const int dvt = it & 3, ch = it >> 2, c = ch >> 2, h = ch & 3; const float lg = lg2gamma(h);
        f32x4 acc[4][2]; ZERO_ACC(acc);
        tile_mm<false, false>(acc, RQ + (size_t)c * 128 * 1024 + h * 256, 1024, SB + ((size_t)ch * 512 + dvt * 128) * 256, 256, 256, lds);
#pragma unroll
        for (int m = 0; m < 4; ++m) { const float xi = exp2f((float)(64 * wr + 16 * m + fr + 1) * lg); acc[m][0] *= xi; acc[m][1] *= xi; }
        tile_mm<false, true>(acc, ATT + (size_t)ch * 16384, 128, RV + (size_t)c * 128 * 2048 + h * 512 + dvt * 128, 2048, 128, lds);
        float* base = ORET + (size_t)c * 128 * 2048 + h * 512 + dvt * 128;
#pragma unroll
        for (int m = 0; m < 4; ++m)
#pragma unroll
            for (int n = 0; n < 2; ++n) *(f32x4*)(base + (size_t)(64 * wr + 16 * m + fr) * 2048 + 32 * wc + 16 * n + 4 * fq) = acc[m][n];
    }
}
__device__ void ret_phase_d(const Params& P) {
    const float* ORET = (const float*)(P.ws + WS_ORET); const bf16_t* RG = (const bf16_t*)(P.ws + WS_RG); bf16_t* YB = (bf16_t*)(P.ws + WS_YB);
    const int wave = otid() >> 6, lane = otid() & 63;
    for (int r = obid() * 8 + wave; r < MT * 4; r += gridDim.x * 8) {
        const size_t off = (size_t)(r >> 2) * 2048 + (r & 3) * 512 + 4 * lane;
        f32x4 a = *(const f32x4*)(ORET + off), b = *(const f32x4*)(ORET + off + 256);
        const float mu = wave_sum((a[0] + a[1]) + (a[2] + a[3]) + (b[0] + b[1]) + (b[2] + b[3])) * (1.0f / 512.0f);
        a -= mu; b -= mu;
        const float rstd = rsqrtf(wave_sum((a[0] * a[0] + a[1] * a[1]) + (a[2] * a[2] + a[3] * a[3]) + (b[0] * b[0] + b[1] * b[1]) + (b[2] * b[2] + b[3] * b[3])) * (1.0f / 512.0f) + LN_EPS);
        const u32x2 ga = *(const u32x2*)(RG + off), gb = *(const u32x2*)(RG + off + 256);
        u32x2 w; w.x = cvt_pk_bf16(a[0] * rstd * bflo(ga.x), a[1] * rstd * bfhi(ga.x)); w.y = cvt_pk_bf16(a[2] * rstd * bflo(ga.y), a[3] * rstd * bfhi(ga.y));
        *(u32x2*)(YB + off) = w;
        w.x = cvt_pk_bf16(b[0] * rstd * bflo(gb.x), b[1] * rstd * bfhi(gb.x)); w.y = cvt_pk_bf16(b[2] * rstd * bflo(gb.y), b[3] * rstd * bfhi(gb.y));
        *(u32x2*)(YB + off + 256) = w;
    }
}

__global__ void __launch_bounds__(512, 2) fwd_kernel(Params P) {
    extern __shared__ __attribute__((aligned(16))) unsigned char lds[];
    cg::grid_group grid = cg::this_grid();
    PG8_LAS unsigned char* l3 = (PG8_LAS unsigned char*)lds;
    for (int ph = P.lo; ph < P.hi; ++ph) {
        if (ph > P.lo) grid.sync();
        unsigned char* ws = P.ws; asm volatile("" : "+s"(ws));
        float* XF = (float*)(ws + WS_XF); bf16_t* XB = (bf16_t*)(ws + WS_XB); float* Z = (float*)(ws + WS_Z); bf16_t* H = (bf16_t*)(ws + WS_H);
        int kind, l = 0, f = 0, lnw = 0;
        if (ph == 0) kind = 0;
        else {
            l = ph > 10 ? 1 : 0; const int q = ph - 1 - 10 * l;
            if (l == 0) { kind = q == 0 ? 1 : q == 1 ? 2 : q == 2 ? 3 : q == 3 ? 4 : q == 4 ? 5 : q == 5 ? 6 : q == 6 ? 3 : q == 7 ? 1 : q == 8 ? 2 : 3;
                f = q >= 7 ? 1 : 0; lnw = q == 2 ? 0 : q == 6 ? 1 : 2; }
            else { kind = q == 0 ? 1 : q == 1 ? 2 : q == 2 ? 3 : q == 3 ? 7 : q == 4 ? 8 : q == 5 ? 9 : q == 6 ? 10 : q == 7 ? 11 : q == 8 ? 12 : q == 9 ? 3 : q == 10 ? 1 : q == 11 ? 2 : 3;
                f = q >= 10 ? 1 : 0; lnw = q == 2 ? 0 : q == 9 ? 1 : 2; }
        }
#ifndef PH_MASK
#define PH_MASK 0xffff
#endif
#define PHON(k) ((PH_MASK >> (k)) & 1)
        if (kind == 0) { if (PHON(0)) phase0(P, lds); }
        else if (kind == 1 && PHON(1)) {
            pg8::Gemm g{XB, (const bf16_t*)(ws + WS_WGU + (size_t)(l * 2 + f) * SZ_WGU), MT, 2 * FF, DM}; pg8::StaticOrder S; S.init(MT, 2 * FF, gridDim.x, obid());
            EpiSwiGLU E{H}; pg8::gemm_phase<EpiSwiGLU, pg8::StaticOrder, false>(l3, g, S, E, nullptr);
        } else if ((kind == 2 || kind == 6 || kind == 12) && PHON(2)) {
            const bf16_t* A; const bf16_t* Bt; int K; float sc;
            if (kind == 2) { A = H; Bt = (const bf16_t*)(ws + WS_WD + (size_t)(l * 2 + f) * SZ_WD); K = FF; sc = 0.5f; }
            else if (kind == 6) { A = (const bf16_t*)(ws + WS_OB); Bt = (const bf16_t*)(ws + WS_WO); K = DM; sc = 1.0f; }
            else { A = (const bf16_t*)(ws + WS_YB); Bt = (const bf16_t*)(ws + WS_WRO); K = 2048; sc = 1.0f; }
                        {
                pg8::Gemm g{A, Bt, TP, DM, K}; pg8::StaticOrder S; S.init(TP, DM, gridDim.x, obid());
                EpiResid E{XF, Z, sc}; pg8::gemm_phase<EpiResid, pg8::StaticOrder, false>(l3, g, S, E, nullptr);
            }
            {
                const int it = obid(), ks = it & 3, tn = (it >> 2) & 7, tm = it >> 5, Kq = K >> 2;
                if (it < 256) {
                    f32x4 acc[4][2]; ZERO_ACC(acc);
                    tile_mm<false, false>(acc, A + (size_t)(TP + tm * 128) * K + ks * Kq, K, Bt + (size_t)(tn * 128) * K + ks * Kq, K, Kq, lds);
                    const int tid = otid(), wave = tid >> 6, lane = tid & 63, wr = wave >> 2, wc = wave & 3, fr = lane & 15, fq = lane >> 4;
                    float* base = (float*)(ws + WS_PART) + (size_t)ks * MS * DM + (size_t)(tm * 128) * DM + tn * 128;
#pragma unroll
                    for (int m = 0; m < 4; ++m)
#pragma unroll
                        for (int n = 0; n < 2; ++n) *(f32x4*)(base + (size_t)(64 * wr + 16 * m + fr) * DM + 32 * wc + 16 * n + 4 * fq) = acc[m][n];
                }
            }
        } else if (kind == 3 && PHON(3)) {
            const bool fin = (ph == NPH - 1); const int li = l * 3 + lnw;
            const float sc = (lnw == 1) ? 1.0f : 0.5f;
            ln_all_phase(Z, XF + (size_t)TP * DM, (const float*)(ws + WS_PART), sc, P.in[11] + (size_t)li * DM, P.in[12] + (size_t)li * DM,
                         fin ? P.out + OUT_Y : XF, (fin ? P.out + OUT_Y : XF) + (size_t)TP * DM, XB);
        } else if (kind == 4 && PHON(4)) {
            pg8::Gemm g{XB, (const bf16_t*)(ws + WS_WQKV), MT, NQKV, DM}; pg8::StaticOrder S; S.init(MT, NQKV, gridDim.x, obid());
            EpiQKV E{(bf16_t*)(ws + WS_QR), (bf16_t*)(ws + WS_KR), (bf16_t*)(ws + WS_VB), (const float*)(ws + WS_ROPEA), P.out};
            pg8::gemm_phase<EpiQKV, pg8::StaticOrder, false>(l3, g, S, E, nullptr);
        } else if (kind == 5 && PHON(5)) attn_phase(P, lds);
        else if (kind == 7 && PHON(7)) {
            pg8::Gemm g{XB, (const bf16_t*)(ws + WS_WRIN), MT, NRIN, DM}; pg8::StaticOrder S; S.init(MT, NRIN, gridDim.x, obid());
            EpiRet E{(bf16_t*)(ws + WS_RQ), (bf16_t*)(ws + WS_RKZ), (bf16_t*)(ws + WS_RV), (bf16_t*)(ws + WS_RG), (const float*)(ws + WS_ROPER)};
            pg8::gemm_phase<EpiRet, pg8::StaticOrder, false>(l3, g, S, E, nullptr);
        } else if (kind == 8 && PHON(8)) ret_phase_a(P, lds);
        else if (kind == 9 && PHON(9)) ret_phase_b(P);
        else if (kind == 10 && PHON(10)) ret_phase_c(P, lds);
        else if (kind == 11 && PHON(11)) ret_phase_d(P);
        __syncthreads();
    }
}

extern "C" void kernel_launch(void* const* d_in, const int* in_sizes, int n_in, void* d_out, int out_size, void* d_ws, size_t ws_size, hipStream_t stream) {
    static int grid = 0;
    if (grid == 0) {
        if (n_in != 18 || (size_t)out_size != OUT_END || ws_size < WS_END2) { fprintf(stderr, "kernel_launch: unexpected shapes: n_in %d out %d ws %zu (need %zu)\n", n_in, out_size, ws_size, (size_t)WS_END2); grid = -1; return; }
        int dev = 0, cus = 0, per_cu = 0;
        hipGetDevice(&dev); hipDeviceGetAttribute(&cus, hipDeviceAttributeMultiprocessorCount, dev);
        if (hipFuncSetAttribute((const void*)fwd_kernel, hipFuncAttributeMaxDynamicSharedMemorySize, LDS_BYTES) != hipSuccess) { fprintf(stderr, "kernel_launch: hipFuncSetAttribute failed\n"); grid = -1; return; }
        if (hipOccupancyMaxActiveBlocksPerMultiprocessor(&per_cu, (const void*)fwd_kernel, 512, LDS_BYTES) != hipSuccess || per_cu < 1) { fprintf(stderr, "kernel_launch: occupancy query says %d\n", per_cu); per_cu = 1; }
        (void)hipGetLastError();
        grid = cus;
        if (grid != 256) { fprintf(stderr, "kernel_launch: built for 256 CUs (fused LayerNorm exchange), got %d\n", grid); grid = -1; return; }
    }
    if (grid < 0) return;
    Params p{};
    for (int i = 0; i < 18; ++i) p.in[i] = (const float*)d_in[i];
    p.out = (float*)d_out; p.ws = (unsigned char*)d_ws;
    if (hipMemsetAsync((char*)d_ws + WS_CNT, 0, 6 * 16384 + 256, stream) != hipSuccess) { fprintf(stderr, "kernel_launch: memset failed\n"); return; }
#if ONE_LAUNCH
    p.lo = 0; p.hi = NPH;
    { void* args[] = {&p}; hipError_t e = hipLaunchCooperativeKernel((const void*)fwd_kernel, dim3(grid), dim3(512), args, LDS_BYTES, stream);
      if (e != hipSuccess) fprintf(stderr, "cooperative launch failed: %s (grid %d)\n", hipGetErrorString(e), grid); }
#else
    for (int ph = 0; ph < NPH; ++ph) { p.lo = ph; p.hi = ph + 1; void* args[] = {&p};
        hipError_t e = hipLaunchCooperativeKernel((const void*)fwd_kernel, dim3(grid), dim3(512), args, LDS_BYTES, stream);
        if (e != hipSuccess) { fprintf(stderr, "cooperative launch %d failed: %s (grid %d)\n", ph, hipGetErrorString(e), grid); break; } }
#endif
}
```
